# Optimizing an MI355X kernel written in HIP

```python
import math
import jax, jax.numpy as jnp
from jax import lax
import numpy as np

D_MODEL = 1024
BATCH = 16
SEQ = 2048
DEPTH = 1

D_S5 = 512
S5_GROUP = 16
S5_GROUPS = D_S5 // S5_GROUP
S5_STATE = 64
D_HY = 512
HY_ORDER = 2
HY_SHORT = 3
HY_BANDS = 16
HY_EMB = 1 + 2 * HY_BANDS
HY_HIDDEN = 64
HY_FAST_DECAY = math.log(1e-2) / 0.3
HY_SLOW_DECAY = math.log(1e-2) / 1.5
N_DIRS = 2
N_BRANCH = 2
D_FF = -(-8 * D_MODEL // (3 * 256)) * 256
D_IN = D_S5 + (HY_ORDER + 1) * D_HY + N_BRANCH * D_MODEL
EPS = 1e-6

kernel_name = "hybrid_s5_hyena_gated_encoder_block"


def _rmsnorm(x, g):
    xf = x.astype(jnp.float32)
    r = xf * lax.rsqrt(jnp.mean(xf * xf, axis=-1, keepdims=True) + EPS)
    return (r * g.astype(jnp.float32)).astype(x.dtype)


def _modulate(h, shift, scale):
    return h * (1.0 + scale[:, None, :]) + shift[:, None, :]


def _s5_scan(u, lam_re, lam_im, log_step, b_re, b_im, c_re, c_im, reverse):
    bsz, seq, _ = u.shape
    lam_re = lam_re.astype(jnp.float32); lam_im = lam_im.astype(jnp.float32)
    b_re = b_re.astype(jnp.float32); b_im = b_im.astype(jnp.float32)
    c_re = c_re.astype(jnp.float32); c_im = c_im.astype(jnp.float32)
    step = jnp.exp(log_step.astype(jnp.float32))[:, None]
    mag = jnp.exp(lam_re * step)
    abar_re = mag * jnp.cos(lam_im * step)
    abar_im = mag * jnp.sin(lam_im * step)
    num_re = abar_re - 1.0
    den = lam_re * lam_re + lam_im * lam_im
    coef_re = (num_re * lam_re + abar_im * lam_im) / den
    coef_im = (abar_im * lam_re - num_re * lam_im) / den
    bb_re = coef_re[..., None] * b_re - coef_im[..., None] * b_im
    bb_im = coef_re[..., None] * b_im + coef_im[..., None] * b_re
    ug = u.reshape(bsz, seq, S5_GROUPS, S5_GROUP)
    bu_re = jnp.einsum('blgc,gpc->lbgp', ug, bb_re)
    bu_im = jnp.einsum('blgc,gpc->lbgp', ug, bb_im)
    a_re = jnp.broadcast_to(abar_re[None, None], (seq, 1, S5_GROUPS, S5_STATE))
    a_im = jnp.broadcast_to(abar_im[None, None], (seq, 1, S5_GROUPS, S5_STATE))

    def combine(left, right):
        ar1, ai1, br1, bi1 = left
        ar2, ai2, br2, bi2 = right
        return (ar2 * ar1 - ai2 * ai1,
                ar2 * ai1 + ai2 * ar1,
                ar2 * br1 - ai2 * bi1 + br2,
                ar2 * bi1 + ai2 * br1 + bi2)

    _, _, s_re, s_im = lax.associative_scan(combine, (a_re, a_im, bu_re, bu_im), reverse=reverse, axis=0)
    y = jnp.einsum('lbgp,gcp->blgc', s_re, c_re) - jnp.einsum('lbgp,gcp->blgc', s_im, c_im)
    return y.reshape(bsz, seq, D_S5)


def _s5_branch(u, lam_re, lam_im, log_step, b_re, b_im, c_re, c_im, d, glu_w, glu_b):
    uf = u.astype(jnp.float32)
    y = uf * d.astype(jnp.float32)
    for direction in range(N_DIRS):
        y = y + _s5_scan(uf, lam_re[direction], lam_im[direction], log_step[direction],
                         b_re[direction], b_im[direction], c_re[direction], c_im[direction],
                         reverse=(direction == 1))
    z = jax.nn.gelu(y.astype(u.dtype))
    return z * jax.nn.sigmoid(z @ glu_w + glu_b)


def _short_conv(u, w, b):
    seq = u.shape[1]
    half = HY_SHORT // 2
    up = jnp.pad(u, ((0, 0), (half, HY_SHORT - 1 - half), (0, 0)))
    y = b
    for k in range(HY_SHORT):
        y = y + up[:, k:k + seq] * w[k]
    return y


def _hyena_filter_spectra(seq, w1, b1, w2, b2, w3, b3, freq, decay):
    t = jnp.arange(seq, dtype=jnp.float32)
    t01 = t / max(seq - 1, 1)
    bands = jnp.linspace(1e-4, HY_BANDS - 1, HY_BANDS, dtype=jnp.float32)
    ang = (2.0 * math.pi) * t[:, None] * bands[None, :] / seq
    feats = jnp.concatenate([t01[:, None], jnp.cos(ang), jnp.sin(ang)], axis=-1)
    f = freq.astype(jnp.float32)
    h = jnp.sin(f * (feats @ w1.astype(jnp.float32) + b1.astype(jnp.float32)))
    h = jnp.sin(f * (h @ w2.astype(jnp.float32) + b2.astype(jnp.float32)))
    h = h @ w3.astype(jnp.float32) + b3.astype(jnp.float32)
    h = h * jnp.exp(-t01[:, None] * jnp.abs(decay.astype(jnp.float32)))
    h = h.reshape(seq, HY_ORDER, N_DIRS, D_HY)
    fwd = h[:, :, 0]
    bwd = h[1:, :, 1]
    circ = jnp.concatenate([fwd, jnp.zeros((1, HY_ORDER, D_HY), jnp.float32), bwd[::-1]], axis=0)
    return jnp.fft.rfft(circ, axis=0)


def _fft_conv(z, kf, bias):
    seq = z.shape[1]
    zf32 = z.astype(jnp.float32)
    zf = jnp.fft.rfft(zf32, n=2 * seq, axis=1)
    y = jnp.fft.irfft(zf * kf[None], n=2 * seq, axis=1)[:, :seq]
    return (y + zf32 * bias.astype(jnp.float32)).astype(z.dtype)


def _hyena_branch(u, conv_w, conv_b, w1, b1, w2, b2, w3, b3, freq, decay, bias):
    seq = u.shape[1]
    u = _short_conv(u, conv_w, conv_b)
    v = u[..., :D_HY]
    gates = (u[..., D_HY:2 * D_HY], u[..., 2 * D_HY:])
    kf = _hyena_filter_spectra(seq, w1, b1, w2, b2, w3, b3, freq, decay)
    z = v
    for o in range(HY_ORDER):
        z = gates[o] * _fft_conv(z, kf[:, o], bias[o])
    return z


def setup_inputs(seed: int = 0) -> dict:
    key = jax.random.key(seed)
    ks = iter(jax.random.split(key, 48))

    def nrm(shape, std):
        return std * jax.random.normal(next(ks), shape, jnp.float32)

    G, P = S5_GROUPS, S5_STATE
    decay_init = jnp.tile(jnp.linspace(HY_FAST_DECAY, HY_SLOW_DECAY, D_HY, dtype=jnp.float32), HY_ORDER * N_DIRS)
    return {
        "x": nrm((BATCH, SEQ, D_MODEL), 1.0),
        "c": nrm((BATCH, D_MODEL), 1.0),
        "ada_w": nrm((DEPTH, D_MODEL, 6 * D_MODEL), 0.5 * D_MODEL ** -0.5),
        "ada_b": nrm((DEPTH, 6 * D_MODEL), 0.02),
        "norm1_g": 1.0 + nrm((DEPTH, D_MODEL), 0.02),
        "norm2_g": 1.0 + nrm((DEPTH, D_MODEL), 0.02),
        "w_in": nrm((DEPTH, D_MODEL, D_IN), D_MODEL ** -0.5),
        "s5_lam_re": -0.5 + nrm((DEPTH, N_DIRS, G, P), 0.01),
        "s5_lam_im": math.pi * jnp.arange(P, dtype=jnp.float32) + nrm((DEPTH, N_DIRS, G, P), 0.01),
        "s5_log_step": jax.random.uniform(next(ks), (DEPTH, N_DIRS, G), jnp.float32, math.log(1e-3), math.log(1e-1)),
        "s5_b_re": nrm((DEPTH, N_DIRS, G, P, S5_GROUP), (2 * S5_GROUP) ** -0.5),
        "s5_b_im": nrm((DEPTH, N_DIRS, G, P, S5_GROUP), (2 * S5_GROUP) ** -0.5),
        "s5_c_re": nrm((DEPTH, N_DIRS, G, S5_GROUP, P), (2 * P) ** -0.5),
        "s5_c_im": nrm((DEPTH, N_DIRS, G, S5_GROUP, P), (2 * P) ** -0.5),
        "s5_d": nrm((DEPTH, D_S5), 1.0),
        "s5_glu_w": nrm((DEPTH, D_S5, D_S5), D_S5 ** -0.5),
        "s5_glu_b": nrm((DEPTH, D_S5), 0.02),
        "hy_conv_w": nrm((DEPTH, HY_SHORT, (HY_ORDER + 1) * D_HY), HY_SHORT ** -0.5),
        "hy_conv_b": nrm((DEPTH, (HY_ORDER + 1) * D_HY), 0.02),
        "hy_ffn_w1": nrm((DEPTH, HY_EMB, HY_HIDDEN), HY_EMB ** -0.5),
        "hy_ffn_b1": nrm((DEPTH, HY_HIDDEN), 0.1),
        "hy_ffn_w2": nrm((DEPTH, HY_HIDDEN, HY_HIDDEN), HY_HIDDEN ** -0.5),
        "hy_ffn_b2": nrm((DEPTH, HY_HIDDEN), 0.1),
        "hy_ffn_w3": nrm((DEPTH, HY_HIDDEN, HY_ORDER * N_DIRS * D_HY), 0.005),
        "hy_ffn_b3": nrm((DEPTH, HY_ORDER * N_DIRS * D_HY), 0.001),
        "hy_freq": 1.0 + nrm((DEPTH, HY_HIDDEN), 0.01),
        "hy_decay": decay_init + nrm((DEPTH, HY_ORDER * N_DIRS * D_HY), 0.01),
        "hy_bias": nrm((DEPTH, HY_ORDER, D_HY), 1.0),
        "w_branch_a": nrm((DEPTH, D_S5, D_MODEL), D_S5 ** -0.5),
        "w_branch_b": nrm((DEPTH, D_HY, D_MODEL), D_HY ** -0.5),
        "w_out": nrm((DEPTH, D_MODEL, D_MODEL), D_MODEL ** -0.5),
        "ffn_w_gu": nrm((DEPTH, D_MODEL, 2 * D_FF), D_MODEL ** -0.5),
        "ffn_w_down": nrm((DEPTH, D_FF, D_MODEL), D_FF ** -0.5),
        "final_g": 1.0 + nrm((D_MODEL,), 0.02),
    }


def reference(x, c, ada_w, ada_b, norm1_g, norm2_g, w_in,
              s5_lam_re, s5_lam_im, s5_log_step, s5_b_re, s5_b_im, s5_c_re, s5_c_im,
              s5_d, s5_glu_w, s5_glu_b,
              hy_conv_w, hy_conv_b, hy_ffn_w1, hy_ffn_b1, hy_ffn_w2, hy_ffn_b2,
              hy_ffn_w3, hy_ffn_b3, hy_freq, hy_decay, hy_bias,
              w_branch_a, w_branch_b, w_out, ffn_w_gu, ffn_w_down, final_g):
    bsz, seq, _ = x.shape
    c_act = jax.nn.silu(c)
    for i in range(DEPTH):
        mod = c_act @ ada_w[i] + ada_b[i]
        sh1, sc1, g1, sh2, sc2, g2 = jnp.split(mod, 6, axis=-1)

        h = _modulate(_rmsnorm(x, norm1_g[i]), sh1, sc1)
        p = h @ w_in[i]
        u_s5 = p[..., :D_S5]
        u_hy = p[..., D_S5:D_S5 + (HY_ORDER + 1) * D_HY]
        gate = jax.nn.sigmoid(p[..., D_S5 + (HY_ORDER + 1) * D_HY:].reshape(bsz, seq, N_BRANCH, D_MODEL))
        y_a = _s5_branch(u_s5, s5_lam_re[i], s5_lam_im[i], s5_log_step[i], s5_b_re[i], s5_b_im[i],
                         s5_c_re[i], s5_c_im[i], s5_d[i], s5_glu_w[i], s5_glu_b[i]) @ w_branch_a[i]
        y_b = _hyena_branch(u_hy, hy_conv_w[i], hy_conv_b[i], hy_ffn_w1[i], hy_ffn_b1[i], hy_ffn_w2[i],
                            hy_ffn_b2[i], hy_ffn_w3[i], hy_ffn_b3[i], hy_freq[i], hy_decay[i],
                            hy_bias[i]) @ w_branch_b[i]
        merged = gate[:, :, 0] * y_a + gate[:, :, 1] * y_b
        x = x + g1[:, None, :] * (merged @ w_out[i])

        h = _modulate(_rmsnorm(x, norm2_g[i]), sh2, sc2)
        gu = h @ ffn_w_gu[i]
        x = x + g2[:, None, :] * ((jax.nn.silu(gu[..., :D_FF]) * gu[..., D_FF:]) @ ffn_w_down[i])
    return _rmsnorm(x, final_g)
```

```cpp
#include <hip/hip_runtime.h>
#include <hip/hip_cooperative_groups.h>
#include <cstdio>
#include <cstdint>
namespace cg = cooperative_groups;

typedef unsigned short bf16_t;
typedef short bf16x8 __attribute__((ext_vector_type(8)));
typedef float f32x4 __attribute__((ext_vector_type(4)));
typedef unsigned u32x4 __attribute__((ext_vector_type(4)));
typedef unsigned u32x2 __attribute__((ext_vector_type(2)));

constexpr int DM = 1024, NB = 16, SEQ = 2048, NTOK = NB * SEQ, DS5 = 512, DHY = 512, DIN = 4096, DFF = 2816;
constexpr int S5G = 32, S5P = 64, S5C = 16, CT = 32, NCH = SEQ / CT;
constexpr int UEXT_LD = 768;
constexpr int NT = 512;

constexpr size_t al256(size_t x) { return (x + 255) & ~(size_t)255; }
constexpr size_t OFF_MOD   = 0;
constexpr size_t OFF_WIN   = al256(OFF_MOD + (size_t)NB * 6 * DM * 4);
constexpr size_t OFF_WGLU  = al256(OFF_WIN + (size_t)DIN * DM * 2);
constexpr size_t OFF_WA    = al256(OFF_WGLU + (size_t)DS5 * DS5 * 2);
constexpr size_t OFF_WB    = al256(OFF_WA + (size_t)DM * DS5 * 2);
constexpr size_t OFF_WOUT  = al256(OFF_WB + (size_t)DM * DHY * 2);
constexpr size_t OFF_WGU   = al256(OFF_WOUT + (size_t)DM * DM * 2);
constexpr size_t OFF_WDOWN = al256(OFF_WGU + (size_t)2 * DFF * DM * 2);
constexpr size_t OFF_KTAB  = al256(OFF_WDOWN + (size_t)DM * DFF * 2);
constexpr size_t OFF_MCAT  = al256(OFF_KTAB + (size_t)2 * S5G * CT * 256 * 4);
constexpr size_t OFF_PCAT  = al256(OFF_MCAT + (size_t)S5G * 512 * UEXT_LD * 2);
constexpr size_t OFF_H2TAB = al256(OFF_PCAT + (size_t)S5G * 256 * 512 * 2);
constexpr size_t OFF_PW    = al256(OFF_H2TAB + (size_t)SEQ * 64 * 4);
constexpr size_t OFF_CF    = al256(OFF_PW + (size_t)64 * 33 * 64 * 8);
constexpr size_t OFF_HF    = al256(OFF_CF + (size_t)64 * 64 * 8);
constexpr size_t OFF_H1    = al256(OFF_HF + (size_t)2 * DHY * 4096 * 2);
constexpr size_t OFF_UEXT  = al256(OFF_H1 + (size_t)NTOK * DM * 2);
constexpr size_t OFF_UHYT  = al256(OFF_UEXT + (size_t)S5G * 1024 * UEXT_LD * 2);
constexpr size_t OFF_GATE  = al256(OFF_UHYT + (size_t)3 * DHY * NB * SEQ * 2);
constexpr size_t OFF_E     = al256(OFF_GATE + (size_t)NTOK * 2 * DM * 2);
constexpr size_t OFF_ZHY   = al256(OFF_E + (size_t)S5G * 1024 * 256 * 4);
constexpr size_t OFF_BAR   = al256(OFF_ZHY + (size_t)NTOK * DHY * 2);
constexpr size_t WS_END    = al256(OFF_BAR + (size_t)3456 * 4);
constexpr size_t OFF_ZS5   = OFF_H1;
constexpr size_t OFF_ZG    = OFF_H1 + (size_t)NTOK * DS5 * 2;
constexpr size_t OFF_MERGED = OFF_UHYT;
constexpr size_t OFF_ACT   = OFF_UHYT;
constexpr size_t OFF_X1B   = OFF_E;
constexpr size_t OFF_X2B   = OFF_H1;
static_assert(OFF_X1B + (size_t)NTOK * DM * 2 <= OFF_BAR, "x1b overlay");
static_assert((size_t)NTOK * DFF * 2 <= OFF_E - OFF_UHYT, "act overlay");

constexpr int LDS_BYTES = 135168;

struct Params {
  const float* in[34];
  float* out;
  unsigned char* ws;
};

extern __shared__ __attribute__((aligned(16))) unsigned char g_lds[];

typedef float f32x2_ __attribute__((ext_vector_type(2)));
typedef __bf16 bf16x2_ __attribute__((ext_vector_type(2)));
__device__ __forceinline__ unsigned cvt_pk_bf16(float lo, float hi) { const f32x2_ v = {lo, hi}; return __builtin_bit_cast(unsigned, __builtin_convertvector(v, bf16x2_)); }
__device__ __forceinline__ bf16_t f2bf(float f) { return (bf16_t)(cvt_pk_bf16(f, 0.f) & 0xffffu); }
__device__ __forceinline__ float bf2f(unsigned h) { return __uint_as_float(h << 16); }
__device__ __forceinline__ float bflo(unsigned w) { return __uint_as_float(w << 16); }
__device__ __forceinline__ float bfhi(unsigned w) { return __uint_as_float(w & 0xffff0000u); }
__device__ __forceinline__ float sigmoidf_(float x) { return __builtin_amdgcn_rcpf(1.f + __expf(-x)); }
__device__ __forceinline__ float siluf_(float x) { return x * __builtin_amdgcn_rcpf(1.f + __expf(-x)); }
__device__ __forceinline__ float gelu_tanh(float x) {
  const float u = 0.7978845608028654f * (x + 0.044715f * x * x * x);
  return x * __builtin_amdgcn_rcpf(1.f + __expf(-2.f * u));
}
__device__ __forceinline__ float wave_sum(float v) {
#pragma unroll
  for (int o = 1; o < 64; o <<= 1) v += __shfl_xor(v, o);
  return v;
}
__device__ __forceinline__ void sincos_red(double ang, float& s, float& c) {
  const double r = ang - 6.283185307179586476925 * floor(ang * 0.159154943091895335769);
  const float rf = (float)r;
  s = sinf(rf); c = cosf(rf);
}
struct S5Disc { float rho, th, cfr, cfi; };
__device__ __forceinline__ S5Disc s5_disc(const Params& P, int d, int g, int p) {
  const float lr = P.in[7][(d * S5G + g) * S5P + p], li = P.in[8][(d * S5G + g) * S5P + p];
  const float step = expf(P.in[9][d * S5G + g]);
  S5Disc r; r.rho = lr * step; r.th = li * step;
  float s, c; sincos_red((double)r.th, s, c);
  const float mag = expf(r.rho), are = mag * c, aim = mag * s, nr = are - 1.f, den = lr * lr + li * li;
  r.cfr = (nr * lr + aim * li) / den; r.cfi = (aim * lr - nr * li) / den;
  return r;
}
__device__ __forceinline__ void s5_pow(const S5Disc& dsc, int k, float& pr, float& pi) {
  float s, c; sincos_red((double)dsc.th * (double)k, s, c);
  const float m = expf(dsc.rho * (float)k);
  pr = m * c; pi = m * s;
}

constexpr int BM = 256, BK = 64, HALF = 128, HT = HALF * BK;
__device__ __forceinline__ int lds_byte(int r, int c) {
  int st = (r >> 4) * 2 + (c >> 5), rr = r & 15, cc = c & 31, ob = rr * 64 + cc * 2;
  return st * 1024 + (ob ^ (((ob >> 9) & 1) << 5));
}
__device__ __forceinline__ void stage_rc(int b, int& R, int& C) {
  int st = b / 1024, sb = b % 1024, swz = sb ^ (((sb >> 9) & 1) << 5);
  R = (st >> 1) * 16 + swz / 64; C = (st & 1) * 32 + (swz % 64) / 2;
}

__device__ __forceinline__ int perm32(int rho) { const int n = rho >> 4, i = rho & 15; return 8 * (i >> 2) + 4 * n + (i & 3); }
#define LAS __attribute__((address_space(3)))
#define GAS __attribute__((address_space(1)))
struct Unit { const char* A; const char* B; int r0, c0, aux; };
template <class Sched, class Epi>
__device__ __forceinline__ void gemm_phase(const int lda, const int ldb, const int K, const Sched& S, const Epi& E) {
  LAS unsigned char* lds = (LAS unsigned char*)g_lds;
  int tid = threadIdx.x; asm volatile("" : "+v"(tid));
  const int wid = __builtin_amdgcn_readfirstlane(tid >> 6), lane = tid & 63, wr = wid >> 2, wc = wid & 3, fr = lane & 15, fq = lane >> 4;
  const int nt = K / BK;
  unsigned voffA[2], voffB[2];
#pragma unroll
  for (int i = 0; i < 2; ++i) { int R, C; stage_rc(tid * 16 + i * 8192, R, C); const int Rb = (R & ~31) + perm32(R & 31);
    voffA[i] = (unsigned)(R * lda + C) * 2u; voffB[i] = (unsigned)(Rb * ldb + C) * 2u; }
  const size_t kstep = (size_t)(BK * 2);
  const size_t hstepA = (size_t)HALF * lda * 2, hstepB = (size_t)HALF * ldb * 2;
  const unsigned ldsw = (unsigned)wid * 1024u;
  const int aoff = lds_byte(wr * 64 + fr, fq * 8), boff = lds_byte(wc * 32 + fr, fq * 8);
  constexpr int HTB = HALF * BK * 2;
#define G_SA(b, h) (((b) * 2 + (h)) * HTB)
#define G_SB(b, h) ((4 + (b) * 2 + (h)) * HTB)
#define G_STAGE(bufoff, gbase, voff) do { _Pragma("unroll") for (int _i = 0; _i < 2; ++_i) \
    __builtin_amdgcn_global_load_lds((const unsigned*)((const char*)(gbase) + (voff)[_i]), (LAS unsigned*)(lds + (bufoff) + ldsw + _i * 8192), 16, 0, 0); } while (0)
#define G_LDA(dst, b, h) do { _Pragma("unroll") for (int m = 0; m < 4; ++m) _Pragma("unroll") for (int k = 0; k < 2; ++k) dst[m][k] = *(const LAS bf16x8*)(lds + G_SA(b, h) + aoff + m * 2048 + k * 1024); } while (0)
#define G_LDB(dst, b, h) do { _Pragma("unroll") for (int n = 0; n < 2; ++n) _Pragma("unroll") for (int k = 0; k < 2; ++k) dst[n][k] = *(const LAS bf16x8*)(lds + G_SB(b, h) + boff + n * 2048 + k * 1024); } while (0)
#define G_MMA(ai, bj, At_, Bt_) do { __builtin_amdgcn_s_setprio(1); _Pragma("unroll") for (int m = 0; m < 4; ++m) _Pragma("unroll") for (int n = 0; n < 2; ++n) _Pragma("unroll") for (int k = 0; k < 2; ++k) \
    acc[ai][bj][m][n] = __builtin_amdgcn_mfma_f32_16x16x32_bf16(Bt_[n][k], At_[m][k], acc[ai][bj][m][n], 0, 0, 0); __builtin_amdgcn_s_setprio(0); } while (0)
#define G_WAIT_V(n) asm volatile("s_waitcnt vmcnt(" #n ")" ::: "memory")
#define G_WAIT_L(n) asm volatile("s_waitcnt lgkmcnt(" #n ")" ::: "memory")
#define G_BAR __builtin_amdgcn_s_barrier()
#define G_SCHED __builtin_amdgcn_sched_barrier(0)
  Unit cur, nxt; int ui = 0;
  if (!S.next(0, cur)) return;
  f32x4 acc[2][2][4][2];
#pragma unroll
  for (int a = 0; a < 2; ++a)
#pragma unroll
    for (int b = 0; b < 2; ++b)
#pragma unroll
      for (int m = 0; m < 4; ++m)
#pragma unroll
        for (int n = 0; n < 2; ++n) acc[a][b][m][n] = (f32x4){0.f, 0.f, 0.f, 0.f};
  bf16x8 At[4][2], B0[2][2], B1[2][2];
  const char* cA = cur.A; const char* cB = cur.B;
  G_STAGE(G_SB(0, 0), cB, voffB); G_STAGE(G_SB(0, 1), cB + hstepB, voffB); G_STAGE(G_SA(0, 0), cA, voffA); G_STAGE(G_SA(0, 1), cA + hstepA, voffA);
  if (wr == 1) G_BAR;
  G_WAIT_V(2); G_BAR;
  G_STAGE(G_SB(1, 0), cB + kstep, voffB); G_STAGE(G_SA(1, 0), cA + kstep, voffA); G_STAGE(G_SB(1, 1), cB + hstepB + kstep, voffB);
  G_WAIT_V(6); G_BAR;
  for (;;) {
    const bool has_next = S.next(ui + 1, nxt);
    const char* nA = has_next ? nxt.A : cA; const char* nB = has_next ? nxt.B : cB;
    for (int t = 0; t < nt; t += 2) {
      const bool last = (t == nt - 2);
      const char* a1 = cA + (size_t)(t + 1) * kstep;
      const char* a2 = last ? nA : cA + (size_t)(t + 2) * kstep; const char* b2 = last ? nB : cB + (size_t)(t + 2) * kstep;
      const char* a3 = a2 + kstep; const char* b3 = b2 + kstep;
      G_LDB(B0, 0, 0); G_LDB(B1, 0, 1); G_SCHED; G_LDA(At, 0, 0); G_STAGE(G_SA(1, 1), a1 + hstepA, voffA);
      G_WAIT_V(8); G_WAIT_L(0); G_BAR; G_MMA(0, 0, At, B0); G_MMA(0, 1, At, B1); G_BAR; G_SCHED;
      G_LDA(At, 0, 1); G_STAGE(G_SB(0, 0), b2, voffB); G_STAGE(G_SB(0, 1), b2 + hstepB, voffB); G_STAGE(G_SA(0, 0), a2, voffA);
      G_WAIT_V(8); G_WAIT_L(0); G_BAR; G_MMA(1, 0, At, B0); G_MMA(1, 1, At, B1); G_BAR; G_SCHED;
      G_LDB(B0, 1, 0); G_LDB(B1, 1, 1); G_SCHED; G_LDA(At, 1, 0); G_STAGE(G_SA(0, 1), a2 + hstepA, voffA);
      G_WAIT_V(8); G_WAIT_L(0); G_BAR; G_MMA(0, 0, At, B0); G_MMA(0, 1, At, B1); G_BAR; G_SCHED;
      G_LDA(At, 1, 1); G_STAGE(G_SB(1, 0), b3, voffB); G_STAGE(G_SB(1, 1), b3 + hstepB, voffB); G_STAGE(G_SA(1, 0), a3, voffA);
      G_WAIT_V(8); G_WAIT_L(0); G_BAR; G_MMA(1, 0, At, B0); G_MMA(1, 1, At, B1); G_BAR; G_SCHED;
    }
    if (wr == 0) G_BAR;
    if constexpr (Epi::PAIRED) {
#pragma unroll
      for (int ai = 0; ai < 2; ++ai)
#pragma unroll
        for (int m = 0; m < 4; ++m)
          E.store_pair(cur, cur.r0 + ai * HALF + wr * 64 + m * 16 + fr, cur.c0 + wc * 32 + 8 * fq, acc[ai][0][m][0], acc[ai][0][m][1], acc[ai][1][m][0], acc[ai][1][m][1]);
    } else {
      typename Epi::Col cp[2];
#pragma unroll
      for (int bj = 0; bj < 2; ++bj) cp[bj] = E.col_prep(cur, cur.c0 + bj * HALF + wc * 32 + 8 * fq);
#pragma unroll
      for (int ai = 0; ai < 2; ++ai) {
        typename Epi::Aux ax[4][2];
#pragma unroll
        for (int m = 0; m < 4; ++m)
#pragma unroll
          for (int bj = 0; bj < 2; ++bj)
            ax[m][bj] = E.load(cur, cur.r0 + ai * HALF + wr * 64 + m * 16 + fr, cur.c0 + bj * HALF + wc * 32 + 8 * fq);
#pragma unroll
        for (int m = 0; m < 4; ++m)
#pragma unroll
          for (int bj = 0; bj < 2; ++bj)
            E.store(cur, cur.r0 + ai * HALF + wr * 64 + m * 16 + fr, cur.c0 + bj * HALF + wc * 32 + 8 * fq, acc[ai][bj][m][0], acc[ai][bj][m][1], cp[bj], ax[m][bj]);
      }
    }
    if (!has_next) break;
    if (!E.keep_acc(cur)) {
#pragma unroll
      for (int a = 0; a < 2; ++a)
#pragma unroll
        for (int b = 0; b < 2; ++b)
#pragma unroll
          for (int m = 0; m < 4; ++m)
#pragma unroll
            for (int n = 0; n < 2; ++n) acc[a][b][m][n] = (f32x4){0.f, 0.f, 0.f, 0.f};
    }
    cur = nxt; cA = nA; cB = nB; ++ui;
    if (wr == 1) G_BAR;
  }
  G_WAIT_V(0);
  G_BAR;
#undef G_SA
#undef G_SB
#undef G_STAGE
#undef G_LDA
#undef G_LDB
#undef G_MMA
}

struct SchedGrid {
  const char* A; const char* B; int lda, ldb, nM, nN, G, c;
  __device__ __forceinline__ bool next(int i, Unit& u) const {
    const int nwg = nM * nN; const long L = (long)i * G + c; if (L >= nwg) return false;
    int wgid = (int)L; { const int q = nwg / 8, r = nwg % 8, xcd = wgid % 8, off = wgid / 8; wgid = (xcd < r ? xcd * (q + 1) : r * (q + 1) + (xcd - r) * q) + off; }
    const int nig = 8 * nN, gid = wgid / nig, fm = gid * 8, gsz = (nM - fm) < 8 ? (nM - fm) : 8;
    const int pm = fm + ((wgid % nig) % gsz), pn = (wgid % nig) / gsz;
    u.r0 = pm * BM; u.c0 = pn * BM; u.aux = 0;
    u.A = A + (size_t)u.r0 * lda * 2; u.B = B + (size_t)u.c0 * ldb * 2; return true;
  }
};
struct SchedGrouped {
  const char* A; const char* B; int lda, ldb, nN, nunits, G, c;
  __device__ __forceinline__ bool next(int i, Unit& u) const {
    const int L = i * G + c; if (L >= nunits) return false;
    const int tn = L % nN, tm = (L / nN) & 3, g = L / (nN * 4);
    u.r0 = tm * BM; u.c0 = tn * BM; u.aux = g;
    u.A = A + ((size_t)g * 1024 + u.r0) * lda * 2; u.B = B + ((size_t)g * nN * BM + u.c0) * ldb * 2; return true;
  }
};
struct SchedPair {
  const char* A0; const char* B0; const char* A1; const char* B1; int lda, ldb, nM, nN, G, c;
  __device__ __forceinline__ bool next(int i, Unit& u) const {
    const int nwg = nM * nN; const long L = (long)(i >> 1) * G + c; if (L >= nwg) return false;
    int wgid = (int)L; { const int q = nwg / 8, r = nwg % 8, xcd = wgid % 8, off = wgid / 8; wgid = (xcd < r ? xcd * (q + 1) : r * (q + 1) + (xcd - r) * q) + off; }
    const int nig = 8 * nN, gid = wgid / nig, fm = gid * 8, gsz = (nM - fm) < 8 ? (nM - fm) : 8;
    const int pm = fm + ((wgid % nig) % gsz), pn = (wgid % nig) / gsz;
    u.r0 = pm * BM; u.c0 = pn * BM; u.aux = i & 1;
    u.A = ((i & 1) ? A1 : A0) + (size_t)u.r0 * lda * 2; u.B = ((i & 1) ? B1 : B0) + (size_t)u.c0 * ldb * 2; return true;
  }
};

struct NoAux {};
struct F8 { f32x4 a, b; };
__device__ __forceinline__ u32x4 pack8(const f32x4& a, const f32x4& b) { u32x4 w; w.x = cvt_pk_bf16(a[0], a[1]); w.y = cvt_pk_bf16(a[2], a[3]); w.z = cvt_pk_bf16(b[0], b[1]); w.w = cvt_pk_bf16(b[2], b[3]); return w; }
__device__ __forceinline__ F8 unpack8(const u32x4& w) { F8 r; r.a = (f32x4){bflo(w.x), bfhi(w.x), bflo(w.y), bfhi(w.y)}; r.b = (f32x4){bflo(w.z), bfhi(w.z), bflo(w.w), bfhi(w.w)}; return r; }
struct EpiIn {
  typedef NoAux Col; typedef NoAux Aux;
  static constexpr bool PAIRED = false;
  __device__ __forceinline__ bool keep_acc(const Unit&) const { return false; }
  bf16_t* uext; bf16_t* uhyt; bf16_t* gate;
  __device__ __forceinline__ Col col_prep(const Unit&, int) const { return Col{}; }
  __device__ __forceinline__ Aux load(const Unit&, int, int) const { return Aux{}; }
  __device__ __forceinline__ void store(const Unit& un, int row, int col, f32x4& v0, f32x4& v1, const Col&, const Aux&) const {
    const int b = row >> 11, tt = row & 2047;
    if (col < DS5) {
      const int g = col >> 4, cc = col & 15, ch = tt >> 5, s = tt & 31;
      *(u32x4*)(uext + ((size_t)(g * 1024 + b * NCH + ch)) * UEXT_LD + s * 16 + cc) = pack8(v0, v1);
    } else if (col < DS5 + 3 * DHY) {
      const int chn = col - DS5;
      bf16_t* p = uhyt + ((size_t)chn * NB + b) * SEQ + tt;
#pragma unroll
      for (int j = 0; j < 4; ++j) { p[(size_t)j * NB * SEQ] = f2bf(v0[j]); p[(size_t)(4 + j) * NB * SEQ] = f2bf(v1[j]); }
    } else {
      f32x4 s0, s1;
#pragma unroll
      for (int j = 0; j < 4; ++j) { s0[j] = sigmoidf_(v0[j]); s1[j] = sigmoidf_(v1[j]); }
      __builtin_nontemporal_store(pack8(s0, s1), (u32x4*)(gate + (size_t)row * (2 * DM) + (col - DS5 - 3 * DHY)));
    }
  }
};
struct EpiS5E {
  typedef NoAux Col; typedef NoAux Aux;
  static constexpr bool PAIRED = false;
  __device__ __forceinline__ bool keep_acc(const Unit&) const { return false; }
  float* E;
  __device__ __forceinline__ Col col_prep(const Unit&, int) const { return Col{}; }
  __device__ __forceinline__ Aux load(const Unit&, int, int) const { return Aux{}; }
  __device__ __forceinline__ void store(const Unit& un, int row, int col, f32x4& v0, f32x4& v1, const Col&, const Aux&) const {
    float* p = E + ((size_t)un.aux * 1024 + row) * 256 + col; *(f32x4*)p = v0; *(f32x4*)(p + 4) = v1; }
};
struct EpiS5Out {
  typedef NoAux Col; typedef NoAux Aux;
  static constexpr bool PAIRED = false;
  __device__ __forceinline__ bool keep_acc(const Unit&) const { return false; }
  bf16_t* zs5;
  __device__ __forceinline__ Col col_prep(const Unit&, int) const { return Col{}; }
  __device__ __forceinline__ Aux load(const Unit&, int, int) const { return Aux{}; }
  __device__ __forceinline__ void store(const Unit& un, int row, int col, f32x4& v0, f32x4& v1, const Col&, const Aux&) const {
    const int b = row >> 6, ch = row & 63, t = col >> 4, cc = col & 15, g = un.aux;
    const size_t tok = (size_t)b * SEQ + ch * CT + t;
    f32x4 s0, s1;
#pragma unroll
    for (int j = 0; j < 4; ++j) { s0[j] = gelu_tanh(v0[j]); s1[j] = gelu_tanh(v1[j]); }
    *(u32x4*)(zs5 + tok * DS5 + g * 16 + cc) = pack8(s0, s1);
  }
};
struct EpiGlu {
  typedef F8 Col; typedef u32x4 Aux;
  static constexpr bool PAIRED = false;
  __device__ __forceinline__ bool keep_acc(const Unit&) const { return false; }
  const bf16_t* zs5; const float* bias; bf16_t* zg;
  __device__ __forceinline__ Col col_prep(const Unit&, int col) const { F8 r; r.a = *(const f32x4*)(bias + col); r.b = *(const f32x4*)(bias + col + 4); return r; }
  __device__ __forceinline__ Aux load(const Unit&, int row, int col) const { return *(const u32x4*)(zs5 + (size_t)row * DS5 + col); }
  __device__ __forceinline__ void store(const Unit& un, int row, int col, f32x4& v0, f32x4& v1, const Col& bb, const Aux& zw) const {
    const F8 z = unpack8(zw); f32x4 s0, s1;
#pragma unroll
    for (int j = 0; j < 4; ++j) { s0[j] = z.a[j] * sigmoidf_(v0[j] + bb.a[j]); s1[j] = z.b[j] * sigmoidf_(v1[j] + bb.b[j]); }
    *(u32x4*)(zg + (size_t)row * DS5 + col) = pack8(s0, s1);
  }
};
struct EpiMerge {
  struct Aux { u32x4 g0, g1; }; typedef NoAux Col;
  const bf16_t* gate; bf16_t* merged;
  static constexpr bool PAIRED = false;
  __device__ __forceinline__ bool keep_acc(const Unit& un) const { return un.aux == 0; }
  __device__ __forceinline__ Col col_prep(const Unit&, int) const { return Col{}; }
  __device__ __forceinline__ Aux load(const Unit& un, int row, int col) const {
    Aux a; a.g1 = *(const u32x4*)(gate + (size_t)row * (2 * DM) + DM + col);
    a.g0 = (u32x4){0u, 0u, 0u, 0u};
    if (un.aux == 0) a.g0 = *(const u32x4*)(gate + (size_t)row * (2 * DM) + col);
    return a;
  }
  __device__ __forceinline__ void store(const Unit& un, int row, int col, f32x4& v0, f32x4& v1, const Col&, const Aux& a) const {
    const F8 g1 = unpack8(a.g1);
    if (un.aux == 0) {
      const F8 g0 = unpack8(a.g0);
#pragma unroll
      for (int j = 0; j < 4; ++j) { v0[j] = v0[j] * (g0.a[j] * __builtin_amdgcn_rcpf(fmaxf(g1.a[j], 1e-20f))); v1[j] = v1[j] * (g0.b[j] * __builtin_amdgcn_rcpf(fmaxf(g1.b[j], 1e-20f))); }
    } else {
      *(u32x4*)(merged + (size_t)row * DM + col) = pack8(g1.a * v0, g1.b * v1);
    }
  }
};
template <bool BASE_BF16>
struct EpiResid {
  typedef F8 Col; typedef F8 Aux;
  static constexpr bool PAIRED = false;
  __device__ __forceinline__ bool keep_acc(const Unit&) const { return false; }
  const void* base; const float* gmod; bf16_t* out;
  __device__ __forceinline__ Col col_prep(const Unit& un, int col) const { const float* p = gmod + (size_t)(un.r0 >> 11) * 6 * DM + col; F8 r; r.a = *(const f32x4*)p; r.b = *(const f32x4*)(p + 4); return r; }
  __device__ __forceinline__ Aux load(const Unit&, int row, int col) const {
    if (BASE_BF16) return unpack8(*(const u32x4*)((const bf16_t*)base + (size_t)row * DM + col));
    const float* p = (const float*)base + (size_t)row * DM + col; F8 r; r.a = __builtin_nontemporal_load((const f32x4*)p); r.b = __builtin_nontemporal_load((const f32x4*)(p + 4)); return r;
  }
  __device__ __forceinline__ void store(const Unit& un, int row, int col, f32x4& v0, f32x4& v1, const Col& g, const Aux& x) const {
    *(u32x4*)(out + (size_t)row * DM + col) = pack8(x.a + g.a * v0, x.b + g.b * v1);
  }
};
struct EpiGU {
  typedef NoAux Col; typedef NoAux Aux;
  static constexpr bool PAIRED = true;
  __device__ __forceinline__ bool keep_acc(const Unit&) const { return false; }
  bf16_t* act;
  __device__ __forceinline__ Col col_prep(const Unit&, int) const { return Col{}; }
  __device__ __forceinline__ Aux load(const Unit&, int, int) const { return Aux{}; }
  __device__ __forceinline__ void store(const Unit&, int, int, f32x4&, f32x4&, const Col&, const Aux&) const {}
  __device__ __forceinline__ void store_pair(const Unit& un, int row, int col, f32x4& g0, f32x4& g1, f32x4& u0, f32x4& u1) const {
    f32x4 a0, a1;
#pragma unroll
    for (int j = 0; j < 4; ++j) { a0[j] = siluf_(g0[j]) * u0[j]; a1[j] = siluf_(g1[j]) * u1[j]; }
    __builtin_nontemporal_store(pack8(a0, a1), (u32x4*)(act + (size_t)row * DFF + (col >> 8) * 128 + (col & 127)));
  }
};

typedef float f32x2 __attribute__((ext_vector_type(2)));
__device__ __forceinline__ void transpose_item(const float* __restrict__ W, int K, int N, bf16_t* __restrict__ WT, int item, int mode, float* scr, int lane) {
  const int nbn = N / 32, kb = item / nbn, nb = item % nbn, k0 = 64 * kb, n0 = 32 * nb;
#pragma unroll
  for (int i = 0; i < 32; ++i) { const int kk = 2 * i + (lane >> 5); scr[kk * 33 + (lane & 31)] = __builtin_nontemporal_load(&W[(size_t)(k0 + kk) * N + n0 + (lane & 31)]); }
  asm volatile("s_waitcnt lgkmcnt(0)" ::: "memory");
  const int c = lane & 7;
#pragma unroll
  for (int j = 0; j < 4; ++j) { const int n = (lane >> 3) + 8 * j; const float* t = scr + (8 * c) * 33 + n;
    u32x4 o; o.x = cvt_pk_bf16(t[0], t[33]); o.y = cvt_pk_bf16(t[2 * 33], t[3 * 33]); o.z = cvt_pk_bf16(t[4 * 33], t[5 * 33]); o.w = cvt_pk_bf16(t[6 * 33], t[7 * 33]);
    int dn = n0 + n; if (mode == 1) { const int a = (dn < DFF) ? dn : dn - DFF; dn = (a >> 7) * 256 + (a & 127) + ((dn < DFF) ? 0 : 128); }
    *(u32x4*)(WT + (size_t)dn * K + k0 + 8 * c) = o; }
  asm volatile("s_waitcnt lgkmcnt(0)" ::: "memory");
}

__device__ __forceinline__ void phase0(const Params& P, int bid, int G) {
  unsigned char* ws = P.ws; int tid = threadIdx.x; asm volatile("" : "+v"(tid)); const int lane = tid & 63, wave = __builtin_amdgcn_readfirstlane(tid >> 6);
  if (bid < 192) {
    float* cs = (float*)g_lds;
    float* red = (float*)(g_lds + 65536);
    for (int i = tid; i < NB * DM; i += NT) { const int b = i >> 10, k = i & 1023; cs[k * 16 + b] = siluf_(P.in[1][i]); }
    __syncthreads();
    for (int item = bid; item < 192; item += G) {
      const int col0 = item * 32, col = tid & 31, ks = tid >> 5;
      float acc[16];
#pragma unroll
      for (int b = 0; b < 16; ++b) acc[b] = 0.f;
      const float* wp = P.in[2] + (size_t)(ks * 64) * (6 * DM) + col0 + col;
      for (int k0 = 0; k0 < 64; k0 += 16) {
        float w[16];
#pragma unroll
        for (int u = 0; u < 16; ++u) w[u] = __builtin_nontemporal_load(&wp[(size_t)(k0 + u) * (6 * DM)]);
#pragma unroll
        for (int u = 0; u < 16; ++u) {
          const f32x4* c4 = (const f32x4*)(cs + (ks * 64 + k0 + u) * 16);
#pragma unroll
          for (int q = 0; q < 4; ++q) { const f32x4 cv = c4[q]; acc[4 * q] += cv[0] * w[u]; acc[4 * q + 1] += cv[1] * w[u]; acc[4 * q + 2] += cv[2] * w[u]; acc[4 * q + 3] += cv[3] * w[u]; }
        }
      }
#pragma unroll
      for (int b = 0; b < 16; ++b) red[(ks * 16 + b) * 32 + col] = acc[b];
      __syncthreads();
      { const int b = tid >> 5, c = tid & 31; float sum = P.in[3][col0 + c];
#pragma unroll
        for (int q = 0; q < 16; ++q) sum += red[(q * 16 + b) * 32 + c];
        ((float*)(ws + OFF_MOD))[b * 6 * DM + col0 + c] = sum; }
      __syncthreads();
    }
  }
  {
    const int vb = (bid + G - 192 % G) % G;
    for (int dg = vb; dg < 2 * S5G; dg += G) {
      const int d = dg >> 5, g = dg & 31;
      f32x2* pw = (f32x2*)g_lds;
      f32x4* cf = (f32x4*)(g_lds + 33 * 64 * 8);
      __syncthreads();
      if (tid < 64) { const S5Disc ds = s5_disc(P, d, g, tid); cf[tid] = (f32x4){ds.rho, ds.th, ds.cfr, ds.cfi};
        ((f32x2*)(ws + OFF_CF))[dg * 64 + tid] = (f32x2){ds.cfr, ds.cfi}; }
      __syncthreads();
      for (int i = tid; i < 33 * 64; i += NT) { const int k = i >> 6, p = i & 63; const f32x4 c4 = cf[p];
        S5Disc ds; ds.rho = c4[0]; ds.th = c4[1]; ds.cfr = c4[2]; ds.cfi = c4[3];
        float pr, pi; s5_pow(ds, k, pr, pi); pw[i] = (f32x2){pr, pi}; ((f32x2*)(ws + OFF_PW))[(size_t)dg * 33 * 64 + i] = (f32x2){pr, pi}; }
      __syncthreads();
      {
        const int c = tid & 15, k = tid >> 4;
        float acc[16];
#pragma unroll
        for (int j = 0; j < 16; ++j) acc[j] = 0.f;
        const float* crp = P.in[12] + ((size_t)dg * S5C + c) * S5P; const float* cip = P.in[13] + ((size_t)dg * S5C + c) * S5P;
#pragma unroll 4
        for (int p = 0; p < S5P; ++p) {
          const f32x2 pp = pw[k * 64 + p]; const f32x4 c4 = cf[p];
          const float cr = crp[p], ci = cip[p];
          const float wr_ = cr * pp[0] - ci * pp[1], wi_ = cr * pp[1] + ci * pp[0];
          const float w2r = wr_ * c4[2] - wi_ * c4[3], w2i = wr_ * c4[3] + wi_ * c4[2];
          const f32x4* br = (const f32x4*)(P.in[10] + ((size_t)dg * S5P + p) * S5C);
          const f32x4* bi = (const f32x4*)(P.in[11] + ((size_t)dg * S5P + p) * S5C);
#pragma unroll
          for (int q = 0; q < 4; ++q) { const f32x4 a = br[q], b = bi[q];
#pragma unroll
            for (int j = 0; j < 4; ++j) acc[4 * q + j] += w2r * a[j] - w2i * b[j]; }
        }
        float* kt = (float*)(ws + OFF_KTAB) + ((size_t)(dg * CT + k) * 16 + c) * 16;
#pragma unroll
        for (int q = 0; q < 4; ++q) *(f32x4*)(kt + 4 * q) = (f32x4){acc[4 * q], acc[4 * q + 1], acc[4 * q + 2], acc[4 * q + 3]};
      }
    }
  }
  __syncthreads();
  for (int t = bid * 8 + wave; t < SEQ; t += G * 8) {
    const int j = lane;
    const float t01 = (float)t / 2047.f;
    const int bi_ = lane & 15;
    const double band = 1e-4 + (double)bi_ * ((15.0 - 1e-4) / 15.0);
    float sv, cv; sincos_red(6.283185307179586476925 * (double)t * band / 2048.0, sv, cv);
    const float* w1 = P.in[19]; const float* w2 = P.in[21];
    float pre = P.in[20][j] + t01 * w1[j];
#pragma unroll
    for (int i = 0; i < 16; ++i) { pre += __shfl(cv, i) * w1[(1 + i) * 64 + j] + __shfl(sv, i) * w1[(17 + i) * 64 + j]; }
    const float fr_ = P.in[25][j];
    const float h1 = sinf(fr_ * pre);
    float pre2 = P.in[22][j];
#pragma unroll 16
    for (int i = 0; i < 64; ++i) pre2 += __shfl(h1, i) * w2[i * 64 + j];
    ((float*)(ws + OFF_H2TAB))[t * 64 + j] = sinf(fr_ * pre2);
  }
}

template <bool IN_BF16>
__device__ __forceinline__ void norm_mod_rows(const void* __restrict__ xin, const float* __restrict__ g, const float* __restrict__ mod, int sh_off, int sc_off,
                                              bf16_t* __restrict__ out, int bid, int G) {
  const int lane = threadIdx.x & 63, wave = threadIdx.x >> 6;
  for (int row0 = (bid * 8 + wave) * 2; row0 < NTOK; row0 += G * 16) {
    const int b = row0 >> 11;
    f32x4 v[2][4]; float s[2] = {0.f, 0.f};
#pragma unroll
    for (int r = 0; r < 2; ++r)
#pragma unroll
      for (int j = 0; j < 4; ++j) {
        if (IN_BF16) { const u32x2 w = ((const u32x2*)((const bf16_t*)xin + (size_t)(row0 + r) * DM))[lane + 64 * j]; v[r][j] = (f32x4){bflo(w.x), bfhi(w.x), bflo(w.y), bfhi(w.y)}; }
        else v[r][j] = ((const f32x4*)((const float*)xin + (size_t)(row0 + r) * DM))[lane + 64 * j];
        s[r] += (v[r][j][0] * v[r][j][0] + v[r][j][1] * v[r][j][1]) + (v[r][j][2] * v[r][j][2] + v[r][j][3] * v[r][j][3]); }
#pragma unroll
    for (int r = 0; r < 2; ++r) {
      const float rstd = 1.f / sqrtf(wave_sum(s[r]) * (1.f / DM) + 1e-6f);
      u32x2* o = (u32x2*)(out + (size_t)(row0 + r) * DM) + lane;
#pragma unroll
      for (int j = 0; j < 4; ++j) {
        const f32x4 gg = ((const f32x4*)g)[lane + 64 * j];
        const f32x4 sh = ((const f32x4*)(mod + (size_t)b * 6 * DM + sh_off))[lane + 64 * j];
        const f32x4 sc = ((const f32x4*)(mod + (size_t)b * 6 * DM + sc_off))[lane + 64 * j];
        f32x4 q;
#pragma unroll
        for (int e = 0; e < 4; ++e) q[e] = (v[r][j][e] * rstd * gg[e]) * (1.f + sc[e]) + sh[e];
        u32x2 w; w.x = cvt_pk_bf16(q[0], q[1]); w.y = cvt_pk_bf16(q[2], q[3]);
        o[64 * j] = w;
      }
    }
  }
}

__device__ __forceinline__ void phase1(const Params& P, int bid, int G) {
  unsigned char* ws = P.ws; int tid = threadIdx.x; asm volatile("" : "+v"(tid)); const int lane = tid & 63, wave = __builtin_amdgcn_readfirstlane(tid >> 6);
  const float* mod = (const float*)(ws + OFF_MOD);
  if (wave < 4) {
    const float* x = P.in[0]; const float* g = P.in[4]; bf16_t* out = (bf16_t*)(ws + OFF_H1);
    for (int row0 = (bid * 4 + wave) * 2; row0 < NTOK; row0 += G * 8) {
      f32x4 v[2][4]; float s[2] = {0.f, 0.f};
#pragma unroll
      for (int r = 0; r < 2; ++r)
#pragma unroll
        for (int j = 0; j < 4; ++j) { v[r][j] = __builtin_nontemporal_load(&((const f32x4*)(x + (size_t)(row0 + r) * DM))[lane + 64 * j]);
          s[r] += (v[r][j][0] * v[r][j][0] + v[r][j][1] * v[r][j][1]) + (v[r][j][2] * v[r][j][2] + v[r][j][3] * v[r][j][3]); }
      const int b = row0 >> 11;
#pragma unroll
      for (int r = 0; r < 2; ++r) {
        const float rstd = 1.f / sqrtf(wave_sum(s[r]) * (1.f / DM) + 1e-6f);
        u32x2* o = (u32x2*)(out + (size_t)(row0 + r) * DM) + lane;
#pragma unroll
        for (int j = 0; j < 4; ++j) {
          const f32x4 gg = ((const f32x4*)g)[lane + 64 * j];
          const f32x4 sh = ((const f32x4*)(mod + (size_t)b * 6 * DM))[lane + 64 * j];
          const f32x4 sc = ((const f32x4*)(mod + (size_t)b * 6 * DM + DM))[lane + 64 * j];
          f32x4 q;
#pragma unroll
          for (int e = 0; e < 4; ++e) q[e] = (v[r][j][e] * rstd * gg[e]) * (1.f + sc[e]) + sh[e];
          u32x2 w; w.x = cvt_pk_bf16(q[0], q[1]); w.y = cvt_pk_bf16(q[2], q[3]);
          o[64 * j] = w;
        }
      }
    }
    return;
  }
  const int tw = bid * 4 + (wave - 4), NTWAVES = G * 4;
  { float* scr = (float*)(g_lds + 16384 + (wave - 4) * 9216);
    for (int it = tw; it < (DM / 64) * (DIN / 32); it += NTWAVES) transpose_item(P.in[6], DM, DIN, (bf16_t*)(ws + OFF_WIN), it, 0, scr, lane); }
  {
    const float* h2tab = (const float*)(ws + OFF_H2TAB);
    bf16_t* hf = (bf16_t*)(ws + OFF_HF);
    const float* w3 = P.in[23];
    float* wsl = (float*)(g_lds + (wave - 4) * 4096);
    for (int item = tw; item < 1024; item += NTWAVES) {
      const int tb = item & 31, cb4 = item >> 5, t = tb * 64 + lane;
      f32x4 h[16];
#pragma unroll
      for (int q = 0; q < 16; ++q) h[q] = *(const f32x4*)(h2tab + t * 64 + 4 * q);
      const float t01 = (float)t / 2047.f;
      for (int sl = 0; sl < 4; ++sl) {
        const int cb = cb4 * 4 + sl;
        asm volatile("s_waitcnt lgkmcnt(0)" ::: "memory");
#pragma unroll
        for (int k = 0; k < 16; ++k) { const int i = lane + 64 * k, ii = i >> 4, cc = i & 15; wsl[cc * 64 + ii] = w3[ii * 2048 + cb * 16 + cc]; }
        asm volatile("s_waitcnt lgkmcnt(0)" ::: "memory");
        for (int cc = 0; cc < 16; ++cc) {
          const int col = cb * 16 + cc;
          float a = P.in[24][col];
          const f32x4* wv = (const f32x4*)(wsl + cc * 64);
#pragma unroll
          for (int q = 0; q < 16; ++q) { const f32x4 w4 = wv[q]; a += h[q][0] * w4[0] + h[q][1] * w4[1] + h[q][2] * w4[2] + h[q][3] * w4[3]; }
          const float val = a * expf(-t01 * fabsf(P.in[26][col]));
          const int o = col >> 10, dir = (col >> 9) & 1, c = col & 511;
          bf16_t* dst = hf + (size_t)(o * DHY + c) * 4096;
          if (dir == 0) dst[2048 - t] = f2bf(val);
          else { if (t == 0) dst[0] = 0; else dst[2048 + t] = f2bf(val); }
        }
      }
    }
  }
  const int wt = tw * 64 + lane, NWT = NTWAVES * 64;
  const float* ktab = (const float*)(ws + OFF_KTAB);
  bf16_t* mcat = (bf16_t*)(ws + OFF_MCAT);
  for (int idx0 = wt; idx0 < S5G * 512 * (UEXT_LD / 4); idx0 += 4 * NWT) {
    u32x2 wv[4];
#pragma unroll
    for (int u = 0; u < 4; ++u) {
      const int idx = idx0 + u * NWT;
      const int kq = idx % (UEXT_LD / 4), rc = idx / (UEXT_LD / 4), row = rc & 511, g = rc >> 9, t = row >> 4, c = row & 15;
      const int kk = kq * 4;
      float v[4];
      if (kk < 512) {
        const int s = kk >> 4, c0 = kk & 15;
        f32x4 a4 = (f32x4){0.f, 0.f, 0.f, 0.f};
        if (t >= s) a4 += *(const f32x4*)(ktab + (((0 * S5G + g) * CT + (t - s)) * 16 + c) * 16 + c0);
        if (s >= t) a4 += *(const f32x4*)(ktab + (((1 * S5G + g) * CT + (s - t)) * 16 + c) * 16 + c0);
        const float dd = (s == t) ? P.in[14][g * 16 + c] : 0.f;
#pragma unroll
        for (int j = 0; j < 4; ++j) v[j] = a4[j] + ((c == c0 + j) ? dd : 0.f);
      } else {
        const int q = kk - 512, d = q >> 7, comp = (q >> 6) & 1, p0 = q & 63, dg = d * S5G + g;
        const f32x2* pwp = (const f32x2*)(ws + OFF_PW) + ((size_t)dg * 33 + (d == 0 ? (t + 1) : (CT - t))) * 64 + p0;
        const f32x4 cr4 = *(const f32x4*)(P.in[12] + ((size_t)dg * S5C + c) * S5P + p0), ci4 = *(const f32x4*)(P.in[13] + ((size_t)dg * S5C + c) * S5P + p0);
#pragma unroll
        for (int j = 0; j < 4; ++j) { const f32x2 pp = pwp[j]; v[j] = comp == 0 ? (cr4[j] * pp[0] - ci4[j] * pp[1]) : -(cr4[j] * pp[1] + ci4[j] * pp[0]); }
      }
      wv[u].x = cvt_pk_bf16(v[0], v[1]); wv[u].y = cvt_pk_bf16(v[2], v[3]);
    }
#pragma unroll
    for (int u = 0; u < 4; ++u) {
      const int idx = idx0 + u * NWT;
      const int kq = idx % (UEXT_LD / 4), rc = idx / (UEXT_LD / 4);
      *(u32x2*)(mcat + (size_t)rc * UEXT_LD + kq * 4) = wv[u];
    }
  }
  bf16_t* pcat = (bf16_t*)(ws + OFF_PCAT);
  for (int idx0 = wt; idx0 < S5G * 256 * 128; idx0 += 4 * NWT) {
    u32x2 wv[4];
#pragma unroll
    for (int u = 0; u < 4; ++u) {
      const int idx = idx0 + u * NWT;
      const int kq = idx & 127, row = (idx >> 7) & 255, g = idx >> 15;
      const int d = row >> 7, comp = (row >> 6) & 1, p = row & 63, kk = kq * 4, s = kk >> 4, c0 = kk & 15;
      const int dg = d * S5G + g;
      const f32x2 pp = ((const f32x2*)(ws + OFF_PW))[((size_t)dg * 33 + (d == 0 ? (CT - 1 - s) : s)) * 64 + p];
      const f32x2 cfv = ((const f32x2*)(ws + OFF_CF))[dg * 64 + p];
      const float wr_ = pp[0] * cfv[0] - pp[1] * cfv[1], wi_ = pp[0] * cfv[1] + pp[1] * cfv[0];
      const f32x4 br = *(const f32x4*)(P.in[10] + ((size_t)dg * S5P + p) * S5C + c0);
      const f32x4 bi = *(const f32x4*)(P.in[11] + ((size_t)dg * S5P + p) * S5C + c0);
      float v[4];
#pragma unroll
      for (int j = 0; j < 4; ++j) v[j] = comp == 0 ? (wr_ * br[j] - wi_ * bi[j]) : (wr_ * bi[j] + wi_ * br[j]);
      wv[u].x = cvt_pk_bf16(v[0], v[1]); wv[u].y = cvt_pk_bf16(v[2], v[3]);
    }
#pragma unroll
    for (int u = 0; u < 4; ++u) { const int idx = idx0 + u * NWT; *(u32x2*)(pcat + (size_t)idx * 4) = wv[u]; }
  }
}

__device__ __forceinline__ void s5_carry(const Params& P, int bid, int G) {
  unsigned char* ws = P.ws;
  const float* E = (const float*)(ws + OFF_E);
  bf16_t* uext = (bf16_t*)(ws + OFF_UEXT);
  for (int idx = bid * 256 + (threadIdx.x & 255) + (threadIdx.x >> 8) * 256 * G; idx < S5G * NB * 2 * S5P; idx += 2 * 256 * G) {
    const int p = idx & 63, d = (idx >> 6) & 1, b = (idx >> 7) & 15, g = idx >> 11;
    const f32x2 aT = ((const f32x2*)(ws + OFF_PW))[((size_t)(d * S5G + g) * 33 + CT) * 64 + p];
    const float ar = aT[0], ai = aT[1];
    const size_t rbase = (size_t)g * 1024 + b * NCH;
    const float* ep_ = E + rbase * 256 + d * 128 + p; asm volatile("" : "+v"(ep_));
    const GAS float* ep = (const GAS float*)ep_;
    bf16_t* up_ = uext + rbase * UEXT_LD + 512 + d * 128 + p; asm volatile("" : "+v"(up_));
    GAS bf16_t* up = (GAS bf16_t*)up_;
    float er[NCH], ei[NCH];
#pragma unroll
    for (int j = 0; j < NCH; ++j) { er[j] = ep[j * 256]; ei[j] = ep[j * 256 + 64]; }
    float sr = 0.f, si = 0.f;
    if (d == 0) {
#pragma unroll
      for (int j = 0; j < NCH; ++j) {
        up[j * UEXT_LD] = f2bf(sr); up[j * UEXT_LD + 64] = f2bf(si);
        const float nr = ar * sr - ai * si + er[j], ni = ar * si + ai * sr + ei[j]; sr = nr; si = ni; }
    } else {
#pragma unroll
      for (int j = NCH - 1; j >= 0; --j) {
        up[j * UEXT_LD] = f2bf(sr); up[j * UEXT_LD + 64] = f2bf(si);
        const float nr = ar * sr - ai * si + er[j], ni = ar * si + ai * sr + ei[j]; sr = nr; si = ni; }
    }
  }
}

constexpr int HY_RSTRIDE = 8224;
constexpr int HY_ZOFF = 8 * HY_RSTRIDE;
constexpr int HY_ZSTRIDE = 4112;
static_assert(HY_ZOFF + 16 * HY_ZSTRIDE <= LDS_BYTES, "hyena lds");

__device__ __forceinline__ f32x4 hy_conv4(const bf16_t* __restrict__ uhyt, const float* __restrict__ cw, const float* __restrict__ cb, int chn, int b, int t) {
  const bf16_t* u = uhyt + ((size_t)chn * NB + b) * SEQ + t;
  const u32x2 m = *(const u32x2*)u;
  const float um = (t > 0) ? bf2f(u[-1]) : 0.f, up = (t + 4 < SEQ) ? bf2f(u[4]) : 0.f;
  const float u0 = bflo(m.x), u1 = bfhi(m.x), u2 = bflo(m.y), u3 = bfhi(m.y);
  const float w0 = cw[chn], w1 = cw[3 * DHY + chn], w2 = cw[6 * DHY + chn], bb = cb[chn];
  return (f32x4){bb + w0 * um + w1 * u0 + w2 * u1, bb + w0 * u0 + w1 * u1 + w2 * u2, bb + w0 * u1 + w1 * u2 + w2 * u3, bb + w0 * u2 + w1 * u3 + w2 * up};
}

__device__ __forceinline__ void hy_toeplitz(f32x4 (&acc)[16], int wave, int lane) {
  LAS const unsigned char* lds = (LAS const unsigned char*)g_lds;
  const int m = lane & 15, kq = lane >> 4;
  const int cm = (m + 7) >> 3, r = (8 * cm - m);
  LAS const unsigned char* abase = lds + r * HY_RSTRIDE + (kq - cm) * 16 + (2048 - 256 * wave) * 2;
  LAS const unsigned char* bbase = lds + HY_ZOFF + m * HY_ZSTRIDE + kq * 16;
#pragma unroll
  for (int tb = 0; tb < 16; ++tb) acc[tb] = (f32x4){0.f, 0.f, 0.f, 0.f};
  bf16x8 F[16];
#pragma unroll
  for (int f = 0; f < 16; ++f) F[f] = *(LAS const bf16x8*)(abase - 32 * f);
  bf16x8 bcur = *(LAS const bf16x8*)(bbase);
  for (int it = 0; it < 8; ++it) {
    LAS const unsigned char* ab = abase + 512 * it;
    LAS const unsigned char* bb = bbase + 512 * it;
#pragma unroll
    for (int u = 0; u < 8; ++u) {
      acc[14] = __builtin_amdgcn_mfma_f32_16x16x32_bf16(F[(14 - 2 * u) & 15], bcur, acc[14], 0, 0, 0);
      acc[15] = __builtin_amdgcn_mfma_f32_16x16x32_bf16(F[(15 - 2 * u) & 15], bcur, acc[15], 0, 0, 0);
      F[(14 - 2 * u) & 15] = *(LAS const bf16x8*)(ab + 64 * (u + 1));
      F[(15 - 2 * u) & 15] = *(LAS const bf16x8*)(ab + 64 * (u + 1) - 32);
      const bf16x8 bnext = *(LAS const bf16x8*)(bb + 64 * (u + 1));
#pragma unroll
      for (int tb = 0; tb < 14; ++tb)
        acc[tb] = __builtin_amdgcn_mfma_f32_16x16x32_bf16(F[(tb - 2 * u) & 15], bcur, acc[tb], 0, 0, 0);
      bcur = bnext;
      __builtin_amdgcn_sched_barrier(0);
    }
  }
}

struct HyRaw { u32x2 m; unsigned short um, up; };
__device__ __forceinline__ HyRaw hy_raw(const GAS bf16_t* up_, int t) {
  HyRaw r; r.m = *(const GAS u32x2*)up_;
  r.um = up_[t > 0 ? -1 : 0]; r.up = up_[t + 4 < SEQ ? 4 : 3];
  if (t == 0) r.um = 0; if (t + 4 >= SEQ) r.up = 0;
  return r;
}
__device__ __forceinline__ f32x4 hy_conv_raw(const HyRaw& r, float w0, float w1, float w2, float bb) {
  const float um = bf2f(r.um), up = bf2f(r.up), u0 = bflo(r.m.x), u1 = bfhi(r.m.x), u2 = bflo(r.m.y), u3 = bfhi(r.m.y);
  return (f32x4){bb + w0 * um + w1 * u0 + w2 * u1, bb + w0 * u0 + w1 * u1 + w2 * u2, bb + w0 * u1 + w1 * u2 + w2 * u3, bb + w0 * u2 + w1 * u3 + w2 * up};
}
__device__ __forceinline__ void hy_build_filter(const u32x4& raw) {
  const int tid = threadIdx.x;
  *(u32x4*)(g_lds + tid * 16) = raw;
  __syncthreads();
  u32x4 nx = (u32x4){0u, 0u, 0u, 0u};
  if (tid < 511) nx = *(const u32x4*)(g_lds + (tid + 1) * 16);
  const unsigned d[8] = {raw.x, raw.y, raw.z, raw.w, nx.x, nx.y, nx.z, nx.w};
#pragma unroll
  for (int r = 1; r < 8; ++r) {
    u32x4 o;
    if ((r & 1) == 0) { o.x = d[r / 2]; o.y = d[r / 2 + 1]; o.z = d[r / 2 + 2]; o.w = d[r / 2 + 3]; }
    else { const int a = (r - 1) / 2;
      o.x = __builtin_amdgcn_alignbit(d[a + 1], d[a], 16); o.y = __builtin_amdgcn_alignbit(d[a + 2], d[a + 1], 16);
      o.z = __builtin_amdgcn_alignbit(d[a + 3], d[a + 2], 16); o.w = __builtin_amdgcn_alignbit(d[a + 4], d[a + 3], 16); }
    *(u32x4*)(g_lds + r * HY_RSTRIDE + tid * 16) = o;
  }
}

__device__ __forceinline__ void hyena_phase(const Params& P, int bid, int G) {
  unsigned char* ws = P.ws; int tid = threadIdx.x; asm volatile("" : "+v"(tid)); const int lane = tid & 63, wave = __builtin_amdgcn_readfirstlane(tid >> 6);
  LAS unsigned char* lds = (LAS unsigned char*)g_lds;
  const bf16_t* uhyt = (const bf16_t*)(ws + OFF_UHYT);
  const bf16_t* hf = (const bf16_t*)(ws + OFF_HF);
  bf16_t* zhyT = (bf16_t*)(ws + OFF_ZS5);
  const float* cw = P.in[17]; const float* cb = P.in[18];
  const int fr = lane & 15, fq = lane >> 4;
  for (int c = bid; c < DHY; c += G) {
    const u32x4 f0raw = *(const u32x4*)(hf + (size_t)(0 * DHY + c) * 4096 + tid * 8);
    const u32x4 f1raw = *(const u32x4*)(hf + (size_t)(1 * DHY + c) * 4096 + tid * 8);
    __syncthreads();
#pragma unroll 1
    for (int half = 0; half < 2; ++half) {
      f32x4 v[8];
#pragma unroll
      for (int i = 0; i < 8; ++i) { const int task = tid + (half * 8 + i) * NT, b = task >> 9, t = (task & 511) * 4; v[i] = hy_conv4(uhyt, cw, cb, c, b, t); }
#pragma unroll
      for (int i = 0; i < 8; ++i) { const int task = tid + (half * 8 + i) * NT, b = task >> 9, t = (task & 511) * 4;
        u32x2 w; w.x = cvt_pk_bf16(v[i][0], v[i][1]); w.y = cvt_pk_bf16(v[i][2], v[i][3]);
        *(LAS u32x2*)(lds + HY_ZOFF + b * HY_ZSTRIDE + t * 2) = w; }
    }
    hy_build_filter(f0raw);
    __syncthreads();
    f32x4 acc[16];
    hy_toeplitz(acc, wave, lane);
    const float bias0 = P.in[27][c], bias1 = P.in[27][DHY + c];
    u32x2 z1[16];
    {
      const int chn = DHY + c;
      const float w0 = cw[chn], w1 = cw[3 * DHY + chn], w2 = cw[6 * DHY + chn], bb = cb[chn];
      const int tl = 256 * wave + 4 * fq;
      const bf16_t* xp_ = uhyt + ((size_t)chn * NB + fr) * SEQ + tl; asm volatile("" : "+v"(xp_));
      const GAS bf16_t* xp = (const GAS bf16_t*)xp_;
      HyRaw raw[16];
#pragma unroll
      for (int tb = 0; tb < 16; ++tb) raw[tb] = hy_raw(xp + 16 * tb, tl + 16 * tb);
#pragma unroll
      for (int tb = 0; tb < 16; ++tb) {
        const int t = tl + 16 * tb;
        const u32x2 zv = *(LAS const u32x2*)(lds + HY_ZOFF + fr * HY_ZSTRIDE + t * 2);
        const f32x4 x1 = hy_conv_raw(raw[tb], w0, w1, w2, bb);
        z1[tb].x = cvt_pk_bf16(x1[0] * (acc[tb][0] + bias0 * bflo(zv.x)), x1[1] * (acc[tb][1] + bias0 * bfhi(zv.x)));
        z1[tb].y = cvt_pk_bf16(x1[2] * (acc[tb][2] + bias0 * bflo(zv.y)), x1[3] * (acc[tb][3] + bias0 * bfhi(zv.y)));
      }
    }
    __syncthreads();
#pragma unroll
    for (int tb = 0; tb < 16; ++tb) {
      const int t = 256 * wave + 16 * tb + 4 * fq;
      *(LAS u32x2*)(lds + HY_ZOFF + fr * HY_ZSTRIDE + t * 2) = z1[tb];
    }
    hy_build_filter(f1raw);
    __syncthreads();
    hy_toeplitz(acc, wave, lane);
    {
      const int chn = 2 * DHY + c;
      const float w0 = cw[chn], w1 = cw[3 * DHY + chn], w2 = cw[6 * DHY + chn], bb = cb[chn];
      const int tl = 256 * wave + 4 * fq;
      const bf16_t* xp_ = uhyt + ((size_t)chn * NB + fr) * SEQ + tl; asm volatile("" : "+v"(xp_));
      const GAS bf16_t* xp = (const GAS bf16_t*)xp_;
      bf16_t* zp_ = zhyT + ((size_t)c * NB + fr) * SEQ + tl; asm volatile("" : "+v"(zp_));
      GAS bf16_t* zp = (GAS bf16_t*)zp_;
      HyRaw raw[16];
#pragma unroll
      for (int tb = 0; tb < 16; ++tb) raw[tb] = hy_raw(xp + 16 * tb, tl + 16 * tb);
#pragma unroll
      for (int tb = 0; tb < 16; ++tb) {
        const int t = tl + 16 * tb;
        const u32x2 zv = *(LAS const u32x2*)(lds + HY_ZOFF + fr * HY_ZSTRIDE + t * 2);
        const f32x4 x2 = hy_conv_raw(raw[tb], w0, w1, w2, bb);
        u32x2 w;
        w.x = cvt_pk_bf16(x2[0] * (acc[tb][0] + bias1 * bflo(zv.x)), x2[1] * (acc[tb][1] + bias1 * bfhi(zv.x)));
        w.y = cvt_pk_bf16(x2[2] * (acc[tb][2] + bias1 * bflo(zv.y)), x2[3] * (acc[tb][3] + bias1 * bfhi(zv.y)));
        *(GAS u32x2*)(zp + 16 * tb) = w;
      }
    }
  }
  __syncthreads();
}

__device__ __forceinline__ void zhy_transpose(unsigned char* ws, int bid, int G) {
  int tid = threadIdx.x; asm volatile("" : "+v"(tid)); const int lane = tid & 63, wave = __builtin_amdgcn_readfirstlane(tid >> 6);
  LAS unsigned char* tl = (LAS unsigned char*)g_lds + wave * 9216;
  const bf16_t* zhyT = (const bf16_t*)(ws + OFF_ZS5);
  bf16_t* zhy = (bf16_t*)(ws + OFF_ZHY);
  const int r8 = lane >> 3, q8 = lane & 7;
  for (int tile = bid * 8 + wave; tile < 4096; tile += G * 8) {
    const int cb = tile & 7, tb = tile >> 3;
    u32x4 v[8];
#pragma unroll
    for (int i = 0; i < 8; ++i) v[i] = *(const u32x4*)(zhyT + (size_t)(cb * 64 + 8 * i + r8) * NTOK + tb * 64 + q8 * 8);
#pragma unroll
    for (int i = 0; i < 8; ++i) {
      const int cl = 8 * i + r8;
#pragma unroll
      for (int j = 0; j < 8; ++j) {
        const unsigned wv = v[i][j >> 1];
        *(LAS unsigned short*)(tl + (q8 * 8 + j) * 144 + cl * 2) = (unsigned short)((j & 1) ? (wv >> 16) : (wv & 0xffffu));
      }
    }
    asm volatile("s_waitcnt lgkmcnt(0)" ::: "memory");
#pragma unroll
    for (int i = 0; i < 8; ++i) {
      const int tokl = 8 * i + r8;
      const u32x4 o = *(LAS const u32x4*)(tl + tokl * 144 + q8 * 16);
      *(u32x4*)(zhy + (size_t)(tb * 64 + tokl) * DHY + cb * 64 + q8 * 8) = o;
    }
    asm volatile("s_waitcnt lgkmcnt(0)" ::: "memory");
  }
}

__device__ __forceinline__ void late_transposes(const Params& P, int bid, int G) {
  unsigned char* ws = P.ws; int tid = threadIdx.x; asm volatile("" : "+v"(tid)); const int lane = tid & 63, wave = __builtin_amdgcn_readfirstlane(tid >> 6);
  constexpr int I_GLU = (DS5 / 64) * (DS5 / 32), I_A = (DS5 / 64) * (DM / 32), I_B = I_A,
                I_OUT = (DM / 64) * (DM / 32), I_GU = (DM / 64) * (2 * DFF / 32), I_DN = (DFF / 64) * (DM / 32);
  constexpr int NITEMS = I_GLU + I_A + I_B + I_OUT + I_GU + I_DN;
  float* scr = (float*)(g_lds + wave * 9216);
  const int slot = (wave >= 4) ? (bid * 4 + (wave - 4)) * 2 : -1, nslot = G * 12;
  for (int rep = 0; rep < 3; ++rep) {
    int first;
    if (wave >= 4) { if (rep == 2) break; first = (bid * 4 + (wave - 4)) * 2 + rep; } else { if (rep > 0) break; first = G * 8 + bid * 4 + wave; }
    for (int it = first; it < NITEMS; it += nslot) {
      int r = it;
      if (r < I_GLU) { transpose_item(P.in[15], DS5, DS5, (bf16_t*)(ws + OFF_WGLU), r, 0, scr, lane); continue; } r -= I_GLU;
      if (r < I_A) { transpose_item(P.in[28], DS5, DM, (bf16_t*)(ws + OFF_WA), r, 0, scr, lane); continue; } r -= I_A;
      if (r < I_B) { transpose_item(P.in[29], DHY, DM, (bf16_t*)(ws + OFF_WB), r, 0, scr, lane); continue; } r -= I_B;
      if (r < I_OUT) { transpose_item(P.in[30], DM, DM, (bf16_t*)(ws + OFF_WOUT), r, 0, scr, lane); continue; } r -= I_OUT;
      if (r < I_GU) { transpose_item(P.in[31], DM, 2 * DFF, (bf16_t*)(ws + OFF_WGU), r, 1, scr, lane); continue; } r -= I_GU;
      transpose_item(P.in[32], DFF, DM, (bf16_t*)(ws + OFF_WDOWN), r, 0, scr, lane);
    }
  }
  (void)slot;
}

#define XB_TMO      128
#define XB_XCNT(j)  (256  + 64 * (j))
#define XB_XSUB(j)  (1280 + 64 * (j))
#define XB_XGEN(j)  (2304 + 64 * (j))
#define XB_TOP      3328
#define XB_TOPGEN   3392
#define XCD_BAR_WORDS 3456
#define XB_SPIN_CAP (1u << 18)
__device__ __forceinline__ unsigned xb_ld(unsigned* p)              { return __hip_atomic_load(p, __ATOMIC_RELAXED, __HIP_MEMORY_SCOPE_AGENT); }
__device__ __forceinline__ unsigned xb_add(unsigned* p, unsigned v) { return __hip_atomic_fetch_add(p, v, __ATOMIC_RELAXED, __HIP_MEMORY_SCOPE_AGENT); }
__device__ __forceinline__ unsigned xb_xcc_id() { return (unsigned)__builtin_amdgcn_s_getreg((3 << 11) | 20) & 0xFu; }
#define XB_SPIN(cond, bar) do { unsigned _sp = 0; while (cond) { __builtin_amdgcn_s_sleep(1); \
    if ((++_sp & 255u) == 0u) { if (xb_ld(&(bar)[XB_TMO])) break; if (_sp > XB_SPIN_CAP) { atomicAdd(&(bar)[XB_TMO], 1u); break; } } } } while (0)
struct XcdBarrier { unsigned* bar; unsigned x; volatile LAS unsigned* st; };
__device__ __forceinline__ XcdBarrier xcd_barrier_post(unsigned* bar, volatile LAS unsigned* st) {
  XcdBarrier b; b.bar = bar; b.x = xb_xcc_id(); b.st = st;
  if (threadIdx.x == 0) (void)xb_add(&bar[XB_XCNT(b.x)], 1u);
  return b;
}
__device__ __forceinline__ void xcd_barrier_complete(unsigned* bar, unsigned x, unsigned& nloc, unsigned& nx) {
  const unsigned G = gridDim.x * gridDim.y * gridDim.z;
  unsigned sum, cnt, mine, sp = 0u;
  for (;;) {
    sum = 0u; cnt = 0u; mine = 0u;
#pragma unroll
    for (unsigned j = 0; j < 16; ++j) { const unsigned c = xb_ld(&bar[XB_XCNT(j)]); sum += c; cnt += (c > 0u) ? 1u : 0u; mine = (j == x) ? c : mine; }
    if (sum == G) break;
    __builtin_amdgcn_s_sleep(1);
    if ((++sp & 255u) == 0u) { if (xb_ld(&bar[XB_TMO])) break; if (sp > XB_SPIN_CAP) { atomicAdd(&bar[XB_TMO], 1u); break; } }
  }
  nloc = mine > 0u ? mine : 1u; nx = cnt > 0u ? cnt : 1u;
}
__device__ __forceinline__ void xcd_barrier(const XcdBarrier& b) {
  asm volatile("s_waitcnt vmcnt(0)" ::: "memory");
  __syncthreads();
  if (threadIdx.x == 0) {
    unsigned* bar = b.bar;
    __builtin_amdgcn_s_waitcnt(0);
    unsigned nloc = b.st[0], nx = b.st[1];
    if (nloc == 0u) { xcd_barrier_complete(bar, b.x, nloc, nx); b.st[0] = nloc; b.st[1] = nx; }
    const unsigned old = xb_add(&bar[XB_XSUB(b.x)], 1u);
    const unsigned gen = old / nloc;
    if (old + 1u == (gen + 1u) * nloc) {
      __builtin_amdgcn_fence(__ATOMIC_RELEASE, "agent");
      asm volatile("s_waitcnt vmcnt(0)" ::: "memory");
      const unsigned og = xb_add(&bar[XB_TOP], 1u);
      const unsigned tg = og / nx;
      if (og + 1u == (tg + 1u) * nx) xb_add(&bar[XB_TOPGEN], 1u);
      else XB_SPIN(xb_ld(&bar[XB_TOPGEN]) == tg, bar);
      __builtin_amdgcn_fence(__ATOMIC_ACQUIRE, "agent");
      xb_add(&bar[XB_XGEN(b.x)], 1u);
      asm volatile("s_waitcnt vmcnt(0)" ::: "memory");
    } else {
      XB_SPIN(xb_ld(&bar[XB_XGEN(b.x)]) == gen, bar);
      __builtin_amdgcn_fence(__ATOMIC_ACQUIRE, "agent");
      asm volatile("s_waitcnt vmcnt(0)" ::: "memory");
    }
  }
  __syncthreads();
}

__global__ void __launch_bounds__(NT) mega(Params P) {
  cg::grid_group grid = cg::this_grid();
  unsigned char* ws = P.ws;
  const int G = gridDim.x, bid = blockIdx.x;
  const float* mod = (const float*)(ws + OFF_MOD);

  volatile LAS unsigned* xst = (volatile LAS unsigned*)((LAS unsigned char*)g_lds + LDS_BYTES - 16);
  if (threadIdx.x == 0) { xst[0] = 0u; xst[1] = 0u; }
  __syncthreads();
  XcdBarrier xb = xcd_barrier_post((unsigned*)(ws + OFF_BAR), xst);
  phase0(P, bid, G);
  grid.sync();
  phase1(P, bid, G);
  xcd_barrier(xb);
  { EpiIn e{(bf16_t*)(ws + OFF_UEXT), (bf16_t*)(ws + OFF_UHYT), (bf16_t*)(ws + OFF_GATE)};
    SchedGrid sc{(const char*)(ws + OFF_H1), (const char*)(ws + OFF_WIN), DM, DM, NTOK / BM, DIN / BM, G, bid};
    gemm_phase(DM, DM, DM, sc, e); }
  xcd_barrier(xb);
  { EpiS5E e{(float*)(ws + OFF_E)};
    SchedGrouped sc{(const char*)(ws + OFF_UEXT), (const char*)(ws + OFF_PCAT), UEXT_LD, 512, 1, S5G * 4, G, bid};
    gemm_phase(UEXT_LD, 512, 512, sc, e); }
  hyena_phase(P, bid, G);
  xcd_barrier(xb);
  s5_carry(P, bid, G);
  zhy_transpose(ws, bid, G);
  late_transposes(P, bid, G);
  xcd_barrier(xb);
  { EpiS5Out e{(bf16_t*)(ws + OFF_ZS5)};
    SchedGrouped sc{(const char*)(ws + OFF_UEXT), (const char*)(ws + OFF_MCAT), UEXT_LD, UEXT_LD, 2, S5G * 8, G, bid};
    gemm_phase(UEXT_LD, UEXT_LD, UEXT_LD, sc, e); }
  xcd_barrier(xb);
  { EpiGlu e{(const bf16_t*)(ws + OFF_ZS5), P.in[16], (bf16_t*)(ws + OFF_ZG)};
    SchedGrid sc{(const char*)(ws + OFF_ZS5), (const char*)(ws + OFF_WGLU), DS5, DS5, NTOK / BM, DS5 / BM, G, bid};
    gemm_phase(DS5, DS5, DS5, sc, e); }
  xcd_barrier(xb);
  { EpiMerge e{(const bf16_t*)(ws + OFF_GATE), (bf16_t*)(ws + OFF_MERGED)};
    SchedPair sc{(const char*)(ws + OFF_ZG), (const char*)(ws + OFF_WA), (const char*)(ws + OFF_ZHY), (const char*)(ws + OFF_WB), DS5, DS5, NTOK / BM, DM / BM, G, bid};
    gemm_phase(DS5, DS5, DS5, sc, e); }
  xcd_barrier(xb);
  { EpiResid<false> e{P.in[0], mod + 2 * DM, (bf16_t*)(ws + OFF_X1B)};
    SchedGrid sc{(const char*)(ws + OFF_MERGED), (const char*)(ws + OFF_WOUT), DM, DM, NTOK / BM, DM / BM, G, bid};
    gemm_phase(DM, DM, DM, sc, e); }
  xcd_barrier(xb);
  norm_mod_rows<true>(ws + OFF_X1B, P.in[5], mod, 3 * DM, 4 * DM, (bf16_t*)(ws + OFF_H1), bid, G);
  xcd_barrier(xb);
  { EpiGU e{(bf16_t*)(ws + OFF_ACT)};
    SchedGrid sc{(const char*)(ws + OFF_H1), (const char*)(ws + OFF_WGU), DM, DM, NTOK / BM, 2 * DFF / BM, G, bid};
    gemm_phase(DM, DM, DM, sc, e); }
  xcd_barrier(xb);
  { EpiResid<true> e{ws + OFF_X1B, mod + 5 * DM, (bf16_t*)(ws + OFF_X2B)};
    SchedGrid sc{(const char*)(ws + OFF_ACT), (const char*)(ws + OFF_WDOWN), DFF, DFF, NTOK / BM, DM / BM, G, bid};
    gemm_phase(DFF, DFF, DFF, sc, e); }
  xcd_barrier(xb);
  { const int lane = threadIdx.x & 63, wave = threadIdx.x >> 6;
    for (int row0 = (bid * 8 + wave) * 2; row0 < NTOK; row0 += G * 16) {
      f32x4 v[2][4]; float s[2] = {0.f, 0.f};
#pragma unroll
      for (int r = 0; r < 2; ++r) {
        const u32x2* xr = (const u32x2*)((const bf16_t*)(ws + OFF_X2B) + (size_t)(row0 + r) * DM) + lane;
#pragma unroll
        for (int j = 0; j < 4; ++j) { const u32x2 w = __builtin_nontemporal_load(&xr[64 * j]); v[r][j] = (f32x4){bflo(w.x), bfhi(w.x), bflo(w.y), bfhi(w.y)};
          s[r] += (v[r][j][0] * v[r][j][0] + v[r][j][1] * v[r][j][1]) + (v[r][j][2] * v[r][j][2] + v[r][j][3] * v[r][j][3]); }
      }
#pragma unroll
      for (int r = 0; r < 2; ++r) {
        const float rstd = 1.f / sqrtf(wave_sum(s[r]) * (1.f / DM) + 1e-6f);
        f32x4* orow = (f32x4*)(P.out + (size_t)(row0 + r) * DM) + lane;
#pragma unroll
        for (int j = 0; j < 4; ++j) { const f32x4 gg = ((const f32x4*)P.in[33])[lane + 64 * j]; __builtin_nontemporal_store(v[r][j] * rstd * gg, &orow[64 * j]); }
      }
    } }
}

extern "C" void kernel_launch(void* const* d_in, const int* in_sizes, int n_in, void* d_out, int out_size,
                              void* d_ws, size_t ws_size, hipStream_t stream) {
  static int grid_blocks = 0;
  if (!grid_blocks) {
    int dev = 0, cus = 0, per_cu = 0;
    (void)hipGetDevice(&dev);
    (void)hipDeviceGetAttribute(&cus, hipDeviceAttributeMultiprocessorCount, dev);
    (void)hipFuncSetAttribute((const void*)mega, hipFuncAttributeMaxDynamicSharedMemorySize, LDS_BYTES);
    (void)hipOccupancyMaxActiveBlocksPerMultiprocessor(&per_cu, (const void*)mega, NT, LDS_BYTES);
    if (per_cu < 1) { fprintf(stderr, "kernel_launch: occupancy query says %d blocks/CU\n", per_cu); per_cu = 1; }
    grid_blocks = cus;
    if (n_in != 34 || out_size != NTOK * DM || ws_size < WS_END)
      fprintf(stderr, "kernel_launch: unexpected sizes n_in %d out %d ws %zu (need %zu)\n", n_in, out_size, ws_size, (size_t)WS_END);
  }
  (void)hipMemsetAsync((unsigned char*)d_ws + OFF_BAR, 0, XCD_BAR_WORDS * 4, stream);
  Params p{};
  for (int i = 0; i < 34; ++i) p.in[i] = (const float*)d_in[i];
  p.out = (float*)d_out; p.ws = (unsigned char*)d_ws;
  void* args[] = {&p};
  hipError_t e = hipLaunchCooperativeKernel((void*)mega, dim3(grid_blocks), dim3(NT), args, LDS_BYTES, stream);
  if (e != hipSuccess) fprintf(stderr, "cooperative launch failed: %s (grid %d)\n", hipGetErrorString(e), grid_blocks);
}
```

```cpp
#include <hip/hip_runtime.h>
#include <hip/hip_cooperative_groups.h>
#include <cstdio>
#include <cstdint>
namespace cg = cooperative_groups;

typedef unsigned short bf16_t;
typedef short bf16x8 __attribute__((ext_vector_type(8)));
typedef float f32x4 __attribute__((ext_vector_type(4)));
typedef unsigned u32x4 __attribute__((ext_vector_type(4)));
typedef unsigned u32x2 __attribute__((ext_vector_type(2)));

constexpr int DM = 1024, NB = 16, SEQ = 2048, NTOK = NB * SEQ, DS5 = 512, DHY = 512, DIN = 4096, DFF = 2816;
constexpr int S5G = 32, S5P = 64, S5C = 16, CT = 32, NCH = SEQ / CT;
constexpr int UEXT_LD = 768;
constexpr int NT = 512;

constexpr size_t al256(size_t x) { return (x + 255) & ~(size_t)255; }
constexpr size_t OFF_MOD   = 0;
constexpr size_t OFF_WIN   = al256(OFF_MOD + (size_t)NB * 6 * DM * 4);
constexpr size_t OFF_WGLU  = al256(OFF_WIN + (size_t)DIN * DM * 2);
constexpr size_t OFF_WA    = al256(OFF_WGLU + (size_t)DS5 * DS5 * 2);
constexpr size_t OFF_WB    = al256(OFF_WA + (size_t)DM * DS5 * 2);
constexpr size_t OFF_WOUT  = al256(OFF_WB + (size_t)DM * DHY * 2);
constexpr size_t OFF_WGU   = al256(OFF_WOUT + (size_t)DM * DM * 2);
constexpr size_t OFF_WDOWN = al256(OFF_WGU + (size_t)2 * DFF * DM * 2);
constexpr size_t OFF_KTAB  = al256(OFF_WDOWN + (size_t)DM * DFF * 2);
constexpr size_t OFF_MCAT  = al256(OFF_KTAB + (size_t)2 * S5G * CT * 256 * 4);
constexpr size_t OFF_PCAT  = al256(OFF_MCAT + (size_t)S5G * 512 * UEXT_LD * 2);
constexpr size_t OFF_H2TAB = al256(OFF_PCAT + (size_t)S5G * 256 * 512 * 2);
constexpr size_t OFF_PW    = al256(OFF_H2TAB + (size_t)SEQ * 64 * 4);
constexpr size_t OFF_CF    = al256(OFF_PW + (size_t)64 * 33 * 64 * 8);
constexpr size_t OFF_HF    = al256(OFF_CF + (size_t)64 * 64 * 8);
constexpr size_t OFF_H1    = al256(OFF_HF + (size_t)2 * DHY * 4096 * 2);
constexpr size_t OFF_UEXT  = al256(OFF_H1 + (size_t)NTOK * DM * 2);
constexpr size_t OFF_UHYT  = al256(OFF_UEXT + (size_t)S5G * 1024 * UEXT_LD * 2);
constexpr size_t OFF_GATE  = al256(OFF_UHYT + (size_t)3 * DHY * NB * SEQ * 2);
constexpr size_t OFF_E     = al256(OFF_GATE + (size_t)NTOK * 2 * DM * 2);
constexpr size_t OFF_ZHY   = al256(OFF_E + (size_t)S5G * 1024 * 256 * 4);
constexpr size_t OFF_BAR   = al256(OFF_ZHY + (size_t)NTOK * DHY * 2);
constexpr size_t WS_END    = al256(OFF_BAR + (size_t)3456 * 4);
constexpr size_t OFF_ZS5   = OFF_H1;
constexpr size_t OFF_ZG    = OFF_H1 + (size_t)NTOK * DS5 * 2;
constexpr size_t OFF_MERGED = OFF_UHYT;
constexpr size_t OFF_ACT   = OFF_UHYT;
constexpr size_t OFF_X1B   = OFF_E;
constexpr size_t OFF_X2B   = OFF_H1;
static_assert(OFF_X1B + (size_t)NTOK * DM * 2 <= OFF_BAR, "x1b overlay");
static_assert((size_t)NTOK * DFF * 2 <= OFF_E - OFF_UHYT, "act overlay");

constexpr int LDS_BYTES = 135168;

struct Params {
  const float* in[34];
  float* out;
  unsigned char* ws;
};

extern __shared__ __attribute__((aligned(16))) unsigned char g_lds[];

typedef float f32x2_ __attribute__((ext_vector_type(2)));
typedef __bf16 bf16x2_ __attribute__((ext_vector_type(2)));
__device__ __forceinline__ unsigned cvt_pk_bf16(float lo, float hi) { const f32x2_ v = {lo, hi}; return __builtin_bit_cast(unsigned, __builtin_convertvector(v, bf16x2_)); }
__device__ __forceinline__ bf16_t f2bf(float f) { return (bf16_t)(cvt_pk_bf16(f, 0.f) & 0xffffu); }
__device__ __forceinline__ float bf2f(unsigned h) { return __uint_as_float(h << 16); }
__device__ __forceinline__ float bflo(unsigned w) { return __uint_as_float(w << 16); }
__device__ __forceinline__ float bfhi(unsigned w) { return __uint_as_float(w & 0xffff0000u); }
__device__ __forceinline__ float sigmoidf_(float x) { return __builtin_amdgcn_rcpf(1.f + __expf(-x)); }
__device__ __forceinline__ float siluf_(float x) { return x * __builtin_amdgcn_rcpf(1.f + __expf(-x)); }
__device__ __forceinline__ float gelu_tanh(float x) {
  const float u = 0.7978845608028654f * (x + 0.044715f * x * x * x);
  return x * __builtin_amdgcn_rcpf(1.f + __expf(-2.f * u));
}
__device__ __forceinline__ float wave_sum(float v) {
#pragma unroll
  for (int o = 1; o < 64; o <<= 1) v += __shfl_xor(v, o);
  return v;
}
__device__ __forceinline__ void sincos_red(double ang, float& s, float& c) {
  const double r = ang - 6.283185307179586476925 * floor(ang * 0.159154943091895335769);
  const float rf = (float)r;
  s = sinf(rf); c = cosf(rf);
}
struct S5Disc { float rho, th, cfr, cfi; };
__device__ __forceinline__ S5Disc s5_disc(const Params& P, int d, int g, int p) {
  const float lr = P.in[7][(d * S5G + g) * S5P + p], li = P.in[8][(d * S5G + g) * S5P + p];
  const float step = expf(P.in[9][d * S5G + g]);
  S5Disc r; r.rho = lr * step; r.th = li * step;
  float s, c; sincos_red((double)r.th, s, c);
  const float mag = expf(r.rho), are = mag * c, aim = mag * s, nr = are - 1.f, den = lr * lr + li * li;
  r.cfr = (nr * lr + aim * li) / den; r.cfi = (aim * lr - nr * li) / den;
  return r;
}
__device__ __forceinline__ void s5_pow(const S5Disc& dsc, int k, float& pr, float& pi) {
  float s, c; sincos_red((double)dsc.th * (double)k, s, c);
  const float m = expf(dsc.rho * (float)k);
  pr = m * c; pi = m * s;
}

constexpr int BM = 256, BK = 64, HALF = 128, HT = HALF * BK;
__device__ __forceinline__ int lds_byte(int r, int c) {
  int st = (r >> 4) * 2 + (c >> 5), rr = r & 15, cc = c & 31, ob = rr * 64 + cc * 2;
  return st * 1024 + (ob ^ (((ob >> 9) & 1) << 5));
}
__device__ __forceinline__ void stage_rc(int b, int& R, int& C) {
  int st = b / 1024, sb = b % 1024, swz = sb ^ (((sb >> 9) & 1) << 5);
  R = (st >> 1) * 16 + swz / 64; C = (st & 1) * 32 + (swz % 64) / 2;
}

__device__ __forceinline__ int perm32(int rho) { const int n = rho >> 4, i = rho & 15; return 8 * (i >> 2) + 4 * n + (i & 3); }
#define LAS __attribute__((address_space(3)))
struct Unit { const char* A; const char* B; int r0, c0, aux; };
template <class Sched, class Epi>
__device__ __forceinline__ void gemm_phase(const int lda, const int ldb, const int K, const Sched& S, const Epi& E) {
  LAS unsigned char* lds = (LAS unsigned char*)g_lds;
  int tid = threadIdx.x; asm volatile("" : "+v"(tid));
  const int wid = __builtin_amdgcn_readfirstlane(tid >> 6), lane = tid & 63, wr = wid >> 2, wc = wid & 3, fr = lane & 15, fq = lane >> 4;
  const int nt = K / BK;
  unsigned voffA[2], voffB[2];
#pragma unroll
  for (int i = 0; i < 2; ++i) { int R, C; stage_rc(tid * 16 + i * 8192, R, C); const int Rb = (R & ~31) + perm32(R & 31);
    voffA[i] = (unsigned)(R * lda + C) * 2u; voffB[i] = (unsigned)(Rb * ldb + C) * 2u; }
  const size_t kstep = (size_t)(BK * 2);
  const size_t hstepA = (size_t)HALF * lda * 2, hstepB = (size_t)HALF * ldb * 2;
  const unsigned ldsw = (unsigned)wid * 1024u;
  const int aoff = lds_byte(wr * 64 + fr, fq * 8), boff = lds_byte(wc * 32 + fr, fq * 8);
  constexpr int HTB = HALF * BK * 2;
#define G_SA(b, h) (((b) * 2 + (h)) * HTB)
#define G_SB(b, h) ((4 + (b) * 2 + (h)) * HTB)
#define G_STAGE(bufoff, gbase, voff) do { _Pragma("unroll") for (int _i = 0; _i < 2; ++_i) \
    __builtin_amdgcn_global_load_lds((const unsigned*)((const char*)(gbase) + (voff)[_i]), (LAS unsigned*)(lds + (bufoff) + ldsw + _i * 8192), 16, 0, 0); } while (0)
#define G_LDA(dst, b, h) do { _Pragma("unroll") for (int m = 0; m < 4; ++m) _Pragma("unroll") for (int k = 0; k < 2; ++k) dst[m][k] = *(const LAS bf16x8*)(lds + G_SA(b, h) + aoff + m * 2048 + k * 1024); } while (0)
#define G_LDB(dst, b, h) do { _Pragma("unroll") for (int n = 0; n < 2; ++n) _Pragma("unroll") for (int k = 0; k < 2; ++k) dst[n][k] = *(const LAS bf16x8*)(lds + G_SB(b, h) + boff + n * 2048 + k * 1024); } while (0)
#define G_MMA(ai, bj, At_, Bt_) do { __builtin_amdgcn_s_setprio(1); _Pragma("unroll") for (int m = 0; m < 4; ++m) _Pragma("unroll") for (int n = 0; n < 2; ++n) _Pragma("unroll") for (int k = 0; k < 2; ++k) \
    acc[ai][bj][m][n] = __builtin_amdgcn_mfma_f32_16x16x32_bf16(Bt_[n][k], At_[m][k], acc[ai][bj][m][n], 0, 0, 0); __builtin_amdgcn_s_setprio(0); } while (0)
#define G_WAIT_V(n) asm volatile("s_waitcnt vmcnt(" #n ")" ::: "memory")
#define G_WAIT_L(n) asm volatile("s_waitcnt lgkmcnt(" #n ")" ::: "memory")
#define G_BAR __builtin_amdgcn_s_barrier()
#define G_SCHED __builtin_amdgcn_sched_barrier(0)
  Unit cur, nxt; int ui = 0;
  if (!S.next(0, cur)) return;
  f32x4 acc[2][2][4][2];
#pragma unroll
  for (int a = 0; a < 2; ++a)
#pragma unroll
    for (int b = 0; b < 2; ++b)
#pragma unroll
      for (int m = 0; m < 4; ++m)
#pragma unroll
        for (int n = 0; n < 2; ++n) acc[a][b][m][n] = (f32x4){0.f, 0.f, 0.f, 0.f};
  bf16x8 At[4][2], B0[2][2], B1[2][2];
  const char* cA = cur.A; const char* cB = cur.B;
  G_STAGE(G_SB(0, 0), cB, voffB); G_STAGE(G_SB(0, 1), cB + hstepB, voffB); G_STAGE(G_SA(0, 0), cA, voffA); G_STAGE(G_SA(0, 1), cA + hstepA, voffA);
  if (wr == 1) G_BAR;
  G_WAIT_V(2); G_BAR;
  G_STAGE(G_SB(1, 0), cB + kstep, voffB); G_STAGE(G_SA(1, 0), cA + kstep, voffA); G_STAGE(G_SB(1, 1), cB + hstepB + kstep, voffB);
  G_WAIT_V(6); G_BAR;
  for (;;) {
    const bool has_next = S.next(ui + 1, nxt);
    const char* nA = has_next ? nxt.A : cA; const char* nB = has_next ? nxt.B : cB;
    for (int t = 0; t < nt; t += 2) {
      const bool last = (t == nt - 2);
      const char* a1 = cA + (size_t)(t + 1) * kstep;
      const char* a2 = last ? nA : cA + (size_t)(t + 2) * kstep; const char* b2 = last ? nB : cB + (size_t)(t + 2) * kstep;
      const char* a3 = a2 + kstep; const char* b3 = b2 + kstep;
      G_LDB(B0, 0, 0); G_LDB(B1, 0, 1); G_SCHED; G_LDA(At, 0, 0); G_STAGE(G_SA(1, 1), a1 + hstepA, voffA);
      G_WAIT_V(8); G_WAIT_L(0); G_BAR; G_MMA(0, 0, At, B0); G_MMA(0, 1, At, B1); G_BAR; G_SCHED;
      G_LDA(At, 0, 1); G_STAGE(G_SB(0, 0), b2, voffB); G_STAGE(G_SB(0, 1), b2 + hstepB, voffB); G_STAGE(G_SA(0, 0), a2, voffA);
      G_WAIT_V(8); G_WAIT_L(0); G_BAR; G_MMA(1, 0, At, B0); G_MMA(1, 1, At, B1); G_BAR; G_SCHED;
      G_LDB(B0, 1, 0); G_LDB(B1, 1, 1); G_SCHED; G_LDA(At, 1, 0); G_STAGE(G_SA(0, 1), a2 + hstepA, voffA);
      G_WAIT_V(8); G_WAIT_L(0); G_BAR; G_MMA(0, 0, At, B0); G_MMA(0, 1, At, B1); G_BAR; G_SCHED;
      G_LDA(At, 1, 1); G_STAGE(G_SB(1, 0), b3, voffB); G_STAGE(G_SB(1, 1), b3 + hstepB, voffB); G_STAGE(G_SA(1, 0), a3, voffA);
      G_WAIT_V(8); G_WAIT_L(0); G_BAR; G_MMA(1, 0, At, B0); G_MMA(1, 1, At, B1); G_BAR; G_SCHED;
    }
    if (wr == 0) G_BAR;
    if constexpr (Epi::PAIRED) {
#pragma unroll
      for (int ai = 0; ai < 2; ++ai)
#pragma unroll
        for (int m = 0; m < 4; ++m)
          E.store_pair(cur, cur.r0 + ai * HALF + wr * 64 + m * 16 + fr, cur.c0 + wc * 32 + 8 * fq, acc[ai][0][m][0], acc[ai][0][m][1], acc[ai][1][m][0], acc[ai][1][m][1]);
    } else {
      typename Epi::Col cp[2];
#pragma unroll
      for (int bj = 0; bj < 2; ++bj) cp[bj] = E.col_prep(cur, cur.c0 + bj * HALF + wc * 32 + 8 * fq);
#pragma unroll
      for (int ai = 0; ai < 2; ++ai) {
        typename Epi::Aux ax[4][2];
#pragma unroll
        for (int m = 0; m < 4; ++m)
#pragma unroll
          for (int bj = 0; bj < 2; ++bj)
            ax[m][bj] = E.load(cur, cur.r0 + ai * HALF + wr * 64 + m * 16 + fr, cur.c0 + bj * HALF + wc * 32 + 8 * fq);
#pragma unroll
        for (int m = 0; m < 4; ++m)
#pragma unroll
          for (int bj = 0; bj < 2; ++bj)
            E.store(cur, cur.r0 + ai * HALF + wr * 64 + m * 16 + fr, cur.c0 + bj * HALF + wc * 32 + 8 * fq, acc[ai][bj][m][0], acc[ai][bj][m][1], cp[bj], ax[m][bj]);
      }
    }
    if (!has_next) break;
    if (!E.keep_acc(cur)) {
#pragma unroll
      for (int a = 0; a < 2; ++a)
#pragma unroll
        for (int b = 0; b < 2; ++b)
#pragma unroll
          for (int m = 0; m < 4; ++m)
#pragma unroll
            for (int n = 0; n < 2; ++n) acc[a][b][m][n] = (f32x4){0.f, 0.f, 0.f, 0.f};
    }
    cur = nxt; cA = nA; cB = nB; ++ui;
    if (wr == 1) G_BAR;
  }
  G_WAIT_V(0);
  G_BAR;
#undef G_SA
#undef G_SB
#undef G_STAGE
#undef G_LDA
#undef G_LDB
#undef G_MMA
}

struct SchedGrid {
  const char* A; const char* B; int lda, ldb, nM, nN, G, c;
  __device__ __forceinline__ bool next(int i, Unit& u) const {
    const int nwg = nM * nN; const long L = (long)i * G + c; if (L >= nwg) return false;
    int wgid = (int)L; { const int q = nwg / 8, r = nwg % 8, xcd = wgid % 8, off = wgid / 8; wgid = (xcd < r ? xcd * (q + 1) : r * (q + 1) + (xcd - r) * q) + off; }
    const int nig = 8 * nN, gid = wgid / nig, fm = gid * 8, gsz = (nM - fm) < 8 ? (nM - fm) : 8;
    const int pm = fm + ((wgid % nig) % gsz), pn = (wgid % nig) / gsz;
    u.r0 = pm * BM; u.c0 = pn * BM; u.aux = 0;
    u.A = A + (size_t)u.r0 * lda * 2; u.B = B + (size_t)u.c0 * ldb * 2; return true;
  }
};
struct SchedGrouped {
  const char* A; const char* B; int lda, ldb, nN, nunits, G, c;
  __device__ __forceinline__ bool next(int i, Unit& u) const {
    const int L = i * G + c; if (L >= nunits) return false;
    const int tn = L % nN, tm = (L / nN) & 3, g = L / (nN * 4);
    u.r0 = tm * BM; u.c0 = tn * BM; u.aux = g;
    u.A = A + ((size_t)g * 1024 + u.r0) * lda * 2; u.B = B + ((size_t)g * nN * BM + u.c0) * ldb * 2; return true;
  }
};
struct SchedPair {
  const char* A0; const char* B0; const char* A1; const char* B1; int lda, ldb, nM, nN, G, c;
  __device__ __forceinline__ bool next(int i, Unit& u) const {
    const int nwg = nM * nN; const long L = (long)(i >> 1) * G + c; if (L >= nwg) return false;
    int wgid = (int)L; { const int q = nwg / 8, r = nwg % 8, xcd = wgid % 8, off = wgid / 8; wgid = (xcd < r ? xcd * (q + 1) : r * (q + 1) + (xcd - r) * q) + off; }
    const int nig = 8 * nN, gid = wgid / nig, fm = gid * 8, gsz = (nM - fm) < 8 ? (nM - fm) : 8;
    const int pm = fm + ((wgid % nig) % gsz), pn = (wgid % nig) / gsz;
    u.r0 = pm * BM; u.c0 = pn * BM; u.aux = i & 1;
    u.A = ((i & 1) ? A1 : A0) + (size_t)u.r0 * lda * 2; u.B = ((i & 1) ? B1 : B0) + (size_t)u.c0 * ldb * 2; return true;
  }
};

struct NoAux {};
struct F8 { f32x4 a, b; };
__device__ __forceinline__ u32x4 pack8(const f32x4& a, const f32x4& b) { u32x4 w; w.x = cvt_pk_bf16(a[0], a[1]); w.y = cvt_pk_bf16(a[2], a[3]); w.z = cvt_pk_bf16(b[0], b[1]); w.w = cvt_pk_bf16(b[2], b[3]); return w; }
__device__ __forceinline__ F8 unpack8(const u32x4& w) { F8 r; r.a = (f32x4){bflo(w.x), bfhi(w.x), bflo(w.y), bfhi(w.y)}; r.b = (f32x4){bflo(w.z), bfhi(w.z), bflo(w.w), bfhi(w.w)}; return r; }
struct EpiIn {
  typedef NoAux Col; typedef NoAux Aux;
  static constexpr bool PAIRED = false;
  __device__ __forceinline__ bool keep_acc(const Unit&) const { return false; }
  bf16_t* uext; bf16_t* uhyt; bf16_t* gate;
  __device__ __forceinline__ Col col_prep(const Unit&, int) const { return Col{}; }
  __device__ __forceinline__ Aux load(const Unit&, int, int) const { return Aux{}; }
  __device__ __forceinline__ void store(const Unit& un, int row, int col, f32x4& v0, f32x4& v1, const Col&, const Aux&) const {
    const int b = row >> 11, tt = row & 2047;
    if (col < DS5) {
      const int g = col >> 4, cc = col & 15, ch = tt >> 5, s = tt & 31;
      *(u32x4*)(uext + ((size_t)(g * 1024 + b * NCH + ch)) * UEXT_LD + s * 16 + cc) = pack8(v0, v1);
    } else if (col < DS5 + 3 * DHY) {
      const int chn = col - DS5;
      bf16_t* p = uhyt + ((size_t)chn * NB + b) * SEQ + tt;
#pragma unroll
      for (int j = 0; j < 4; ++j) { p[(size_t)j * NB * SEQ] = f2bf(v0[j]); p[(size_t)(4 + j) * NB * SEQ] = f2bf(v1[j]); }
    } else {
      f32x4 s0, s1;
#pragma unroll
      for (int j = 0; j < 4; ++j) { s0[j] = sigmoidf_(v0[j]); s1[j] = sigmoidf_(v1[j]); }
      __builtin_nontemporal_store(pack8(s0, s1), (u32x4*)(gate + (size_t)row * (2 * DM) + (col - DS5 - 3 * DHY)));
    }
  }
};
struct EpiS5E {
  typedef NoAux Col; typedef NoAux Aux;
  static constexpr bool PAIRED = false;
  __device__ __forceinline__ bool keep_acc(const Unit&) const { return false; }
  float* E;
  __device__ __forceinline__ Col col_prep(const Unit&, int) const { return Col{}; }
  __device__ __forceinline__ Aux load(const Unit&, int, int) const { return Aux{}; }
  __device__ __forceinline__ void store(const Unit& un, int row, int col, f32x4& v0, f32x4& v1, const Col&, const Aux&) const {
    float* p = E + ((size_t)un.aux * 1024 + row) * 256 + col; *(f32x4*)p = v0; *(f32x4*)(p + 4) = v1; }
};
struct EpiS5Out {
  typedef NoAux Col; typedef NoAux Aux;
  static constexpr bool PAIRED = false;
  __device__ __forceinline__ bool keep_acc(const Unit&) const { return false; }
  bf16_t* zs5;
  __device__ __forceinline__ Col col_prep(const Unit&, int) const { return Col{}; }
  __device__ __forceinline__ Aux load(const Unit&, int, int) const { return Aux{}; }
  __device__ __forceinline__ void store(const Unit& un, int row, int col, f32x4& v0, f32x4& v1, const Col&, const Aux&) const {
    const int b = row >> 6, ch = row & 63, t = col >> 4, cc = col & 15, g = un.aux;
    const size_t tok = (size_t)b * SEQ + ch * CT + t;
    f32x4 s0, s1;
#pragma unroll
    for (int j = 0; j < 4; ++j) { s0[j] = gelu_tanh(v0[j]); s1[j] = gelu_tanh(v1[j]); }
    *(u32x4*)(zs5 + tok * DS5 + g * 16 + cc) = pack8(s0, s1);
  }
};
struct EpiGlu {
  typedef F8 Col; typedef u32x4 Aux;
  static constexpr bool PAIRED = false;
  __device__ __forceinline__ bool keep_acc(const Unit&) const { return false; }
  const bf16_t* zs5; const float* bias; bf16_t* zg;
  __device__ __forceinline__ Col col_prep(const Unit&, int col) const { F8 r; r.a = *(const f32x4*)(bias + col); r.b = *(const f32x4*)(bias + col + 4); return r; }
  __device__ __forceinline__ Aux load(const Unit&, int row, int col) const { return *(const u32x4*)(zs5 + (size_t)row * DS5 + col); }
  __device__ __forceinline__ void store(const Unit& un, int row, int col, f32x4& v0, f32x4& v1, const Col& bb, const Aux& zw) const {
    const F8 z = unpack8(zw); f32x4 s0, s1;
#pragma unroll
    for (int j = 0; j < 4; ++j) { s0[j] = z.a[j] * sigmoidf_(v0[j] + bb.a[j]); s1[j] = z.b[j] * sigmoidf_(v1[j] + bb.b[j]); }
    *(u32x4*)(zg + (size_t)row * DS5 + col) = pack8(s0, s1);
  }
};
struct EpiMerge {
  struct Aux { u32x4 g0, g1; }; typedef NoAux Col;
  const bf16_t* gate; bf16_t* merged;
  static constexpr bool PAIRED = false;
  __device__ __forceinline__ bool keep_acc(const Unit& un) const { return un.aux == 0; }
  __device__ __forceinline__ Col col_prep(const Unit&, int) const { return Col{}; }
  __device__ __forceinline__ Aux load(const Unit& un, int row, int col) const {
    Aux a; a.g1 = *(const u32x4*)(gate + (size_t)row * (2 * DM) + DM + col);
    a.g0 = (u32x4){0u, 0u, 0u, 0u};
    if (un.aux == 0) a.g0 = *(const u32x4*)(gate + (size_t)row * (2 * DM) + col);
    return a;
  }
  __device__ __forceinline__ void store(const Unit& un, int row, int col, f32x4& v0, f32x4& v1, const Col&, const Aux& a) const {
    const F8 g1 = unpack8(a.g1);
    if (un.aux == 0) {
      const F8 g0 = unpack8(a.g0);
#pragma unroll
      for (int j = 0; j < 4; ++j) { v0[j] = v0[j] * (g0.a[j] * __builtin_amdgcn_rcpf(fmaxf(g1.a[j], 1e-20f))); v1[j] = v1[j] * (g0.b[j] * __builtin_amdgcn_rcpf(fmaxf(g1.b[j], 1e-20f))); }
    } else {
      *(u32x4*)(merged + (size_t)row * DM + col) = pack8(g1.a * v0, g1.b * v1);
    }
  }
};
template <bool BASE_BF16>
struct EpiResid {
  typedef F8 Col; typedef F8 Aux;
  static constexpr bool PAIRED = false;
  __device__ __forceinline__ bool keep_acc(const Unit&) const { return false; }
  const void* base; const float* gmod; bf16_t* out;
  __device__ __forceinline__ Col col_prep(const Unit& un, int col) const { const float* p = gmod + (size_t)(un.r0 >> 11) * 6 * DM + col; F8 r; r.a = *(const f32x4*)p; r.b = *(const f32x4*)(p + 4); return r; }
  __device__ __forceinline__ Aux load(const Unit&, int row, int col) const {
    if (BASE_BF16) return unpack8(*(const u32x4*)((const bf16_t*)base + (size_t)row * DM + col));
    const float* p = (const float*)base + (size_t)row * DM + col; F8 r; r.a = __builtin_nontemporal_load((const f32x4*)p); r.b = __builtin_nontemporal_load((const f32x4*)(p + 4)); return r;
  }
  __device__ __forceinline__ void store(const Unit& un, int row, int col, f32x4& v0, f32x4& v1, const Col& g, const Aux& x) const {
    *(u32x4*)(out + (size_t)row * DM + col) = pack8(x.a + g.a * v0, x.b + g.b * v1);
  }
};
struct EpiGU {
  typedef NoAux Col; typedef NoAux Aux;
  static constexpr bool PAIRED = true;
  __device__ __forceinline__ bool keep_acc(const Unit&) const { return false; }
  bf16_t* act;
  __device__ __forceinline__ Col col_prep(const Unit&, int) const { return Col{}; }
  __device__ __forceinline__ Aux load(const Unit&, int, int) const { return Aux{}; }
  __device__ __forceinline__ void store(const Unit&, int, int, f32x4&, f32x4&, const Col&, const Aux&) const {}
  __device__ __forceinline__ void store_pair(const Unit& un, int row, int col, f32x4& g0, f32x4& g1, f32x4& u0, f32x4& u1) const {
    f32x4 a0, a1;
#pragma unroll
    for (int j = 0; j < 4; ++j) { a0[j] = siluf_(g0[j]) * u0[j]; a1[j] = siluf_(g1[j]) * u1[j]; }
    __builtin_nontemporal_store(pack8(a0, a1), (u32x4*)(act + (size_t)row * DFF + (col >> 8) * 128 + (col & 127)));
  }
};

typedef float f32x2 __attribute__((ext_vector_type(2)));
__device__ __forceinline__ void transpose_item(const float* __restrict__ W, int K, int N, bf16_t* __restrict__ WT, int item, int mode, float* scr, int lane) {
  const int nbn = N / 32, kb = item / nbn, nb = item % nbn, k0 = 64 * kb, n0 = 32 * nb;
#pragma unroll
  for (int i = 0; i < 32; ++i) { const int kk = 2 * i + (lane >> 5); scr[kk * 33 + (lane & 31)] = __builtin_nontemporal_load(&W[(size_t)(k0 + kk) * N + n0 + (lane & 31)]); }
  asm volatile("s_waitcnt lgkmcnt(0)" ::: "memory");
  const int c = lane & 7;
#pragma unroll
  for (int j = 0; j < 4; ++j) { const int n = (lane >> 3) + 8 * j; const float* t = scr + (8 * c) * 33 + n;
    u32x4 o; o.x = cvt_pk_bf16(t[0], t[33]); o.y = cvt_pk_bf16(t[2 * 33], t[3 * 33]); o.z = cvt_pk_bf16(t[4 * 33], t[5 * 33]); o.w = cvt_pk_bf16(t[6 * 33], t[7 * 33]);
    int dn = n0 + n; if (mode == 1) { const int a = (dn < DFF) ? dn : dn - DFF; dn = (a >> 7) * 256 + (a & 127) + ((dn < DFF) ? 0 : 128); }
    *(u32x4*)(WT + (size_t)dn * K + k0 + 8 * c) = o; }
  asm volatile("s_waitcnt lgkmcnt(0)" ::: "memory");
}

__device__ __forceinline__ void phase0(const Params& P, int bid, int G) {
  unsigned char* ws = P.ws; int tid = threadIdx.x; asm volatile("" : "+v"(tid)); const int lane = tid & 63, wave = __builtin_amdgcn_readfirstlane(tid >> 6);
  if (bid < 192) {
    float* cs = (float*)g_lds;
    float* red = (float*)(g_lds + 65536);
    for (int i = tid; i < NB * DM; i += NT) { const int b = i >> 10, k = i & 1023; cs[k * 16 + b] = siluf_(P.in[1][i]); }
    __syncthreads();
    for (int item = bid; item < 192; item += G) {
      const int col0 = item * 32, col = tid & 31, ks = tid >> 5;
      float acc[16];
#pragma unroll
      for (int b = 0; b < 16; ++b) acc[b] = 0.f;
      const float* wp = P.in[2] + (size_t)(ks * 64) * (6 * DM) + col0 + col;
      for (int k0 = 0; k0 < 64; k0 += 16) {
        float w[16];
#pragma unroll
        for (int u = 0; u < 16; ++u) w[u] = __builtin_nontemporal_load(&wp[(size_t)(k0 + u) * (6 * DM)]);
#pragma unroll
        for (int u = 0; u < 16; ++u) {
          const f32x4* c4 = (const f32x4*)(cs + (ks * 64 + k0 + u) * 16);
#pragma unroll
          for (int q = 0; q < 4; ++q) { const f32x4 cv = c4[q]; acc[4 * q] += cv[0] * w[u]; acc[4 * q + 1] += cv[1] * w[u]; acc[4 * q + 2] += cv[2] * w[u]; acc[4 * q + 3] += cv[3] * w[u]; }
        }
      }
#pragma unroll
      for (int b = 0; b < 16; ++b) red[(ks * 16 + b) * 32 + col] = acc[b];
      __syncthreads();
      { const int b = tid >> 5, c = tid & 31; float sum = P.in[3][col0 + c];
#pragma unroll
        for (int q = 0; q < 16; ++q) sum += red[(q * 16 + b) * 32 + c];
        ((float*)(ws + OFF_MOD))[b * 6 * DM + col0 + c] = sum; }
      __syncthreads();
    }
  }
  {
    const int vb = (bid + G - 192 % G) % G;
    for (int dg = vb; dg < 2 * S5G; dg += G) {
      const int d = dg >> 5, g = dg & 31;
      f32x2* pw = (f32x2*)g_lds;
      f32x4* cf = (f32x4*)(g_lds + 33 * 64 * 8);
      __syncthreads();
      if (tid < 64) { const S5Disc ds = s5_disc(P, d, g, tid); cf[tid] = (f32x4){ds.rho, ds.th, ds.cfr, ds.cfi};
        ((f32x2*)(ws + OFF_CF))[dg * 64 + tid] = (f32x2){ds.cfr, ds.cfi}; }
      __syncthreads();
      for (int i = tid; i < 33 * 64; i += NT) { const int k = i >> 6, p = i & 63; const f32x4 c4 = cf[p];
        S5Disc ds; ds.rho = c4[0]; ds.th = c4[1]; ds.cfr = c4[2]; ds.cfi = c4[3];
        float pr, pi; s5_pow(ds, k, pr, pi); pw[i] = (f32x2){pr, pi}; ((f32x2*)(ws + OFF_PW))[(size_t)dg * 33 * 64 + i] = (f32x2){pr, pi}; }
      __syncthreads();
      {
        const int c = tid & 15, k = tid >> 4;
        float acc[16];
#pragma unroll
        for (int j = 0; j < 16; ++j) acc[j] = 0.f;
        const float* crp = P.in[12] + ((size_t)dg * S5C + c) * S5P; const float* cip = P.in[13] + ((size_t)dg * S5C + c) * S5P;
#pragma unroll 4
        for (int p = 0; p < S5P; ++p) {
          const f32x2 pp = pw[k * 64 + p]; const f32x4 c4 = cf[p];
          const float cr = crp[p], ci = cip[p];
          const float wr_ = cr * pp[0] - ci * pp[1], wi_ = cr * pp[1] + ci * pp[0];
          const float w2r = wr_ * c4[2] - wi_ * c4[3], w2i = wr_ * c4[3] + wi_ * c4[2];
          const f32x4* br = (const f32x4*)(P.in[10] + ((size_t)dg * S5P + p) * S5C);
          const f32x4* bi = (const f32x4*)(P.in[11] + ((size_t)dg * S5P + p) * S5C);
#pragma unroll
          for (int q = 0; q < 4; ++q) { const f32x4 a = br[q], b = bi[q];
#pragma unroll
            for (int j = 0; j < 4; ++j) acc[4 * q + j] += w2r * a[j] - w2i * b[j]; }
        }
        float* kt = (float*)(ws + OFF_KTAB) + ((size_t)(dg * CT + k) * 16 + c) * 16;
#pragma unroll
        for (int q = 0; q < 4; ++q) *(f32x4*)(kt + 4 * q) = (f32x4){acc[4 * q], acc[4 * q + 1], acc[4 * q + 2], acc[4 * q + 3]};
      }
    }
  }
  __syncthreads();
  for (int t = bid * 8 + wave; t < SEQ; t += G * 8) {
    const int j = lane;
    const float t01 = (float)t / 2047.f;
    const int bi_ = lane & 15;
    const double band = 1e-4 + (double)bi_ * ((15.0 - 1e-4) / 15.0);
    float sv, cv; sincos_red(6.283185307179586476925 * (double)t * band / 2048.0, sv, cv);
    const float* w1 = P.in[19]; const float* w2 = P.in[21];
    float pre = P.in[20][j] + t01 * w1[j];
#pragma unroll
    for (int i = 0; i < 16; ++i) { pre += __shfl(cv, i) * w1[(1 + i) * 64 + j] + __shfl(sv, i) * w1[(17 + i) * 64 + j]; }
    const float fr_ = P.in[25][j];
    const float h1 = sinf(fr_ * pre);
    float pre2 = P.in[22][j];
#pragma unroll 16
    for (int i = 0; i < 64; ++i) pre2 += __shfl(h1, i) * w2[i * 64 + j];
    ((float*)(ws + OFF_H2TAB))[t * 64 + j] = sinf(fr_ * pre2);
  }
}

template <bool IN_BF16>
__device__ __forceinline__ void norm_mod_rows(const void* __restrict__ xin, const float* __restrict__ g, const float* __restrict__ mod, int sh_off, int sc_off,
                                              bf16_t* __restrict__ out, int bid, int G) {
  const int lane = threadIdx.x & 63, wave = threadIdx.x >> 6;
  for (int row0 = (bid * 8 + wave) * 2; row0 < NTOK; row0 += G * 16) {
    const int b = row0 >> 11;
    f32x4 v[2][4]; float s[2] = {0.f, 0.f};
#pragma unroll
    for (int r = 0; r < 2; ++r)
#pragma unroll
      for (int j = 0; j < 4; ++j) {
        if (IN_BF16) { const u32x2 w = ((const u32x2*)((const bf16_t*)xin + (size_t)(row0 + r) * DM))[lane + 64 * j]; v[r][j] = (f32x4){bflo(w.x), bfhi(w.x), bflo(w.y), bfhi(w.y)}; }
        else v[r][j] = ((const f32x4*)((const float*)xin + (size_t)(row0 + r) * DM))[lane + 64 * j];
        s[r] += (v[r][j][0] * v[r][j][0] + v[r][j][1] * v[r][j][1]) + (v[r][j][2] * v[r][j][2] + v[r][j][3] * v[r][j][3]); }
#pragma unroll
    for (int r = 0; r < 2; ++r) {
      const float rstd = 1.f / sqrtf(wave_sum(s[r]) * (1.f / DM) + 1e-6f);
      u32x2* o = (u32x2*)(out + (size_t)(row0 + r) * DM) + lane;
#pragma unroll
      for (int j = 0; j < 4; ++j) {
        const f32x4 gg = ((const f32x4*)g)[lane + 64 * j];
        const f32x4 sh = ((const f32x4*)(mod + (size_t)b * 6 * DM + sh_off))[lane + 64 * j];
        const f32x4 sc = ((const f32x4*)(mod + (size_t)b * 6 * DM + sc_off))[lane + 64 * j];
        f32x4 q;
#pragma unroll
        for (int e = 0; e < 4; ++e) q[e] = (v[r][j][e] * rstd * gg[e]) * (1.f + sc[e]) + sh[e];
        u32x2 w; w.x = cvt_pk_bf16(q[0], q[1]); w.y = cvt_pk_bf16(q[2], q[3]);
        o[64 * j] = w;
      }
    }
  }
}

__device__ __forceinline__ void phase1(const Params& P, int bid, int G) {
  unsigned char* ws = P.ws; int tid = threadIdx.x; asm volatile("" : "+v"(tid)); const int lane = tid & 63, wave = __builtin_amdgcn_readfirstlane(tid >> 6);
  const float* mod = (const float*)(ws + OFF_MOD);
  if (wave < 4) {
    const float* x = P.in[0]; const float* g = P.in[4]; bf16_t* out = (bf16_t*)(ws + OFF_H1);
    for (int row0 = (bid * 4 + wave) * 2; row0 < NTOK; row0 += G * 8) {
      f32x4 v[2][4]; float s[2] = {0.f, 0.f};
#pragma unroll
      for (int r = 0; r < 2; ++r)
#pragma unroll
        for (int j = 0; j < 4; ++j) { v[r][j] = __builtin_nontemporal_load(&((const f32x4*)(x + (size_t)(row0 + r) * DM))[lane + 64 * j]);
          s[r] += (v[r][j][0] * v[r][j][0] + v[r][j][1] * v[r][j][1]) + (v[r][j][2] * v[r][j][2] + v[r][j][3] * v[r][j][3]); }
      const int b = row0 >> 11;
#pragma unroll
      for (int r = 0; r < 2; ++r) {
        const float rstd = 1.f / sqrtf(wave_sum(s[r]) * (1.f / DM) + 1e-6f);
        u32x2* o = (u32x2*)(out + (size_t)(row0 + r) * DM) + lane;
#pragma unroll
        for (int j = 0; j < 4; ++j) {
          const f32x4 gg = ((const f32x4*)g)[lane + 64 * j];
          const f32x4 sh = ((const f32x4*)(mod + (size_t)b * 6 * DM))[lane + 64 * j];
          const f32x4 sc = ((const f32x4*)(mod + (size_t)b * 6 * DM + DM))[lane + 64 * j];
          f32x4 q;
#pragma unroll
          for (int e = 0; e < 4; ++e) q[e] = (v[r][j][e] * rstd * gg[e]) * (1.f + sc[e]) + sh[e];
          u32x2 w; w.x = cvt_pk_bf16(q[0], q[1]); w.y = cvt_pk_bf16(q[2], q[3]);
          o[64 * j] = w;
        }
      }
    }
    return;
  }
  const int tw = bid * 4 + (wave - 4), NTWAVES = G * 4;
  { float* scr = (float*)(g_lds + 16384 + (wave - 4) * 9216);
    for (int it = tw; it < (DM / 64) * (DIN / 32); it += NTWAVES) transpose_item(P.in[6], DM, DIN, (bf16_t*)(ws + OFF_WIN), it, 0, scr, lane); }
  {
    const float* h2tab = (const float*)(ws + OFF_H2TAB);
    bf16_t* hf = (bf16_t*)(ws + OFF_HF);
    const float* w3 = P.in[23];
    float* wsl = (float*)(g_lds + (wave - 4) * 4096);
    for (int item = tw; item < 1024; item += NTWAVES) {
      const int tb = item & 31, cb4 = item >> 5, t = tb * 64 + lane;
      f32x4 h[16];
#pragma unroll
      for (int q = 0; q < 16; ++q) h[q] = *(const f32x4*)(h2tab + t * 64 + 4 * q);
      const float t01 = (float)t / 2047.f;
      for (int sl = 0; sl < 4; ++sl) {
        const int cb = cb4 * 4 + sl;
        asm volatile("s_waitcnt lgkmcnt(0)" ::: "memory");
#pragma unroll
        for (int k = 0; k < 16; ++k) { const int i = lane + 64 * k, ii = i >> 4, cc = i & 15; wsl[cc * 64 + ii] = w3[ii * 2048 + cb * 16 + cc]; }
        asm volatile("s_waitcnt lgkmcnt(0)" ::: "memory");
        for (int cc = 0; cc < 16; ++cc) {
          const int col = cb * 16 + cc;
          float a = P.in[24][col];
          const f32x4* wv = (const f32x4*)(wsl + cc * 64);
#pragma unroll
          for (int q = 0; q < 16; ++q) { const f32x4 w4 = wv[q]; a += h[q][0] * w4[0] + h[q][1] * w4[1] + h[q][2] * w4[2] + h[q][3] * w4[3]; }
          const float val = a * expf(-t01 * fabsf(P.in[26][col]));
          const int o = col >> 10, dir = (col >> 9) & 1, c = col & 511;
          bf16_t* dst = hf + (size_t)(o * DHY + c) * 4096;
          if (dir == 0) dst[2048 - t] = f2bf(val);
          else { if (t == 0) dst[0] = 0; else dst[2048 + t] = f2bf(val); }
        }
      }
    }
  }
  const int wt = tw * 64 + lane, NWT = NTWAVES * 64;
  const float* ktab = (const float*)(ws + OFF_KTAB);
  bf16_t* mcat = (bf16_t*)(ws + OFF_MCAT);
  for (int idx0 = wt; idx0 < S5G * 512 * (UEXT_LD / 4); idx0 += 4 * NWT) {
    u32x2 wv[4];
#pragma unroll
    for (int u = 0; u < 4; ++u) {
      const int idx = idx0 + u * NWT;
      const int kq = idx % (UEXT_LD / 4), rc = idx / (UEXT_LD / 4), row = rc & 511, g = rc >> 9, t = row >> 4, c = row & 15;
      const int kk = kq * 4;
      float v[4];
      if (kk < 512) {
        const int s = kk >> 4, c0 = kk & 15;
        f32x4 a4 = (f32x4){0.f, 0.f, 0.f, 0.f};
        if (t >= s) a4 += *(const f32x4*)(ktab + (((0 * S5G + g) * CT + (t - s)) * 16 + c) * 16 + c0);
        if (s >= t) a4 += *(const f32x4*)(ktab + (((1 * S5G + g) * CT + (s - t)) * 16 + c) * 16 + c0);
        const float dd = (s == t) ? P.in[14][g * 16 + c] : 0.f;
#pragma unroll
        for (int j = 0; j < 4; ++j) v[j] = a4[j] + ((c == c0 + j) ? dd : 0.f);
      } else {
        const int q = kk - 512, d = q >> 7, comp = (q >> 6) & 1, p0 = q & 63, dg = d * S5G + g;
        const f32x2* pwp = (const f32x2*)(ws + OFF_PW) + ((size_t)dg * 33 + (d == 0 ? (t + 1) : (CT - t))) * 64 + p0;
        const f32x4 cr4 = *(const f32x4*)(P.in[12] + ((size_t)dg * S5C + c) * S5P + p0), ci4 = *(const f32x4*)(P.in[13] + ((size_t)dg * S5C + c) * S5P + p0);
#pragma unroll
        for (int j = 0; j < 4; ++j) { const f32x2 pp = pwp[j]; v[j] = comp == 0 ? (cr4[j] * pp[0] - ci4[j] * pp[1]) : -(cr4[j] * pp[1] + ci4[j] * pp[0]); }
      }
      wv[u].x = cvt_pk_bf16(v[0], v[1]); wv[u].y = cvt_pk_bf16(v[2], v[3]);
    }
#pragma unroll
    for (int u = 0; u < 4; ++u) {
      const int idx = idx0 + u * NWT;
      const int kq = idx % (UEXT_LD / 4), rc = idx / (UEXT_LD / 4);
      *(u32x2*)(mcat + (size_t)rc * UEXT_LD + kq * 4) = wv[u];
    }
  }
  bf16_t* pcat = (bf16_t*)(ws + OFF_PCAT);
  for (int idx0 = wt; idx0 < S5G * 256 * 128; idx0 += 4 * NWT) {
    u32x2 wv[4];
#pragma unroll
    for (int u = 0; u < 4; ++u) {
      const int idx = idx0 + u * NWT;
      const int kq = idx & 127, row = (idx >> 7) & 255, g = idx >> 15;
      const int d = row >> 7, comp = (row >> 6) & 1, p = row & 63, kk = kq * 4, s = kk >> 4, c0 = kk & 15;
      const int dg = d * S5G + g;
      const f32x2 pp = ((const f32x2*)(ws + OFF_PW))[((size_t)dg * 33 + (d == 0 ? (CT - 1 - s) : s)) * 64 + p];
      const f32x2 cfv = ((const f32x2*)(ws + OFF_CF))[dg * 64 + p];
      const float wr_ = pp[0] * cfv[0] - pp[1] * cfv[1], wi_ = pp[0] * cfv[1] + pp[1] * cfv[0];
      const f32x4 br = *(const f32x4*)(P.in[10] + ((size_t)dg * S5P + p) * S5C + c0);
      const f32x4 bi = *(const f32x4*)(P.in[11] + ((size_t)dg * S5P + p) * S5C + c0);
      float v[4];
#pragma unroll
      for (int j = 0; j < 4; ++j) v[j] = comp == 0 ? (wr_ * br[j] - wi_ * bi[j]) : (wr_ * bi[j] + wi_ * br[j]);
      wv[u].x = cvt_pk_bf16(v[0], v[1]); wv[u].y = cvt_pk_bf16(v[2], v[3]);
    }
#pragma unroll
    for (int u = 0; u < 4; ++u) { const int idx = idx0 + u * NWT; *(u32x2*)(pcat + (size_t)idx * 4) = wv[u]; }
  }
}

__device__ __forceinline__ void s5_carry(const Params& P, int bid, int G) {
  unsigned char* ws = P.ws;
  const float* E = (const float*)(ws + OFF_E);
  bf16_t* uext = (bf16_t*)(ws + OFF_UEXT);
  for (int idx = bid * 256 + (threadIdx.x & 255) + (threadIdx.x >> 8) * 256 * G; idx < S5G * NB * 2 * S5P; idx += 2 * 256 * G) {
    const int p = idx & 63, d = (idx >> 6) & 1, b = (idx >> 7) & 15, g = idx >> 11;
    const f32x2 aT = ((const f32x2*)(ws + OFF_PW))[((size_t)(d * S5G + g) * 33 + CT) * 64 + p];
    const float ar = aT[0], ai = aT[1];
    const size_t rbase = (size_t)g * 1024 + b * NCH;
    const float* ep = E + rbase * 256 + d * 128 + p; asm volatile("" : "+v"(ep));
    bf16_t* up = uext + rbase * UEXT_LD + 512 + d * 128 + p; asm volatile("" : "+v"(up));
    float er[NCH], ei[NCH];
#pragma unroll
    for (int j = 0; j < NCH; ++j) { er[j] = ep[j * 256]; ei[j] = ep[j * 256 + 64]; }
    float sr = 0.f, si = 0.f;
    if (d == 0) {
#pragma unroll
      for (int j = 0; j < NCH; ++j) {
        up[j * UEXT_LD] = f2bf(sr); up[j * UEXT_LD + 64] = f2bf(si);
        const float nr = ar * sr - ai * si + er[j], ni = ar * si + ai * sr + ei[j]; sr = nr; si = ni; }
    } else {
#pragma unroll
      for (int j = NCH - 1; j >= 0; --j) {
        up[j * UEXT_LD] = f2bf(sr); up[j * UEXT_LD + 64] = f2bf(si);
        const float nr = ar * sr - ai * si + er[j], ni = ar * si + ai * sr + ei[j]; sr = nr; si = ni; }
    }
  }
}

constexpr int HY_RSTRIDE = 8224;
constexpr int HY_ZOFF = 8 * HY_RSTRIDE;
constexpr int HY_ZSTRIDE = 4112;
static_assert(HY_ZOFF + 16 * HY_ZSTRIDE <= LDS_BYTES, "hyena lds");

__device__ __forceinline__ f32x4 hy_conv4(const bf16_t* __restrict__ uhyt, const float* __restrict__ cw, const float* __restrict__ cb, int chn, int b, int t) {
  const bf16_t* u = uhyt + ((size_t)chn * NB + b) * SEQ + t;
  const u32x2 m = *(const u32x2*)u;
  const float um = (t > 0) ? bf2f(u[-1]) : 0.f, up = (t + 4 < SEQ) ? bf2f(u[4]) : 0.f;
  const float u0 = bflo(m.x), u1 = bfhi(m.x), u2 = bflo(m.y), u3 = bfhi(m.y);
  const float w0 = cw[chn], w1 = cw[3 * DHY + chn], w2 = cw[6 * DHY + chn], bb = cb[chn];
  return (f32x4){bb + w0 * um + w1 * u0 + w2 * u1, bb + w0 * u0 + w1 * u1 + w2 * u2, bb + w0 * u1 + w1 * u2 + w2 * u3, bb + w0 * u2 + w1 * u3 + w2 * up};
}

__device__ __forceinline__ void hy_toeplitz(f32x4 (&acc)[16], int wave, int lane) {
  LAS const unsigned char* lds = (LAS const unsigned char*)g_lds;
  const int m = lane & 15, kq = lane >> 4;
  const int cm = (m + 7) >> 3, r = (8 * cm - m);
  LAS const unsigned char* abase = lds + r * HY_RSTRIDE + (kq - cm) * 16 + (2048 - 256 * wave) * 2;
  LAS const unsigned char* bbase = lds + HY_ZOFF + m * HY_ZSTRIDE + kq * 16;
#pragma unroll
  for (int tb = 0; tb < 16; ++tb) acc[tb] = (f32x4){0.f, 0.f, 0.f, 0.f};
  bf16x8 F[16];
#pragma unroll
  for (int f = 0; f < 16; ++f) F[f] = *(LAS const bf16x8*)(abase - 32 * f);
  bf16x8 bcur = *(LAS const bf16x8*)(bbase);
  for (int it = 0; it < 8; ++it) {
    LAS const unsigned char* ab = abase + 512 * it;
    LAS const unsigned char* bb = bbase + 512 * it;
#pragma unroll
    for (int u = 0; u < 8; ++u) {
      acc[14] = __builtin_amdgcn_mfma_f32_16x16x32_bf16(F[(14 - 2 * u) & 15], bcur, acc[14], 0, 0, 0);
      acc[15] = __builtin_amdgcn_mfma_f32_16x16x32_bf16(F[(15 - 2 * u) & 15], bcur, acc[15], 0, 0, 0);
      F[(14 - 2 * u) & 15] = *(LAS const bf16x8*)(ab + 64 * (u + 1));
      F[(15 - 2 * u) & 15] = *(LAS const bf16x8*)(ab + 64 * (u + 1) - 32);
      const bf16x8 bnext = *(LAS const bf16x8*)(bb + 64 * (u + 1));
#pragma unroll
      for (int tb = 0; tb < 14; ++tb)
        acc[tb] = __builtin_amdgcn_mfma_f32_16x16x32_bf16(F[(tb - 2 * u) & 15], bcur, acc[tb], 0, 0, 0);
      bcur = bnext;
      __builtin_amdgcn_sched_barrier(0);
    }
  }
}

struct HyRaw { u32x2 m; unsigned short um, up; };
__device__ __forceinline__ HyRaw hy_raw(const bf16_t* __restrict__ up_, int t) {
  HyRaw r; r.m = *(const u32x2*)up_;
  r.um = up_[t > 0 ? -1 : 0]; r.up = up_[t + 4 < SEQ ? 4 : 3];
  if (t == 0) r.um = 0; if (t + 4 >= SEQ) r.up = 0;
  return r;
}
__device__ __forceinline__ f32x4 hy_conv_raw(const HyRaw& r, float w0, float w1, float w2, float bb) {
  const float um = bf2f(r.um), up = bf2f(r.up), u0 = bflo(r.m.x), u1 = bfhi(r.m.x), u2 = bflo(r.m.y), u3 = bfhi(r.m.y);
  return (f32x4){bb + w0 * um + w1 * u0 + w2 * u1, bb + w0 * u0 + w1 * u1 + w2 * u2, bb + w0 * u1 + w1 * u2 + w2 * u3, bb + w0 * u2 + w1 * u3 + w2 * up};
}
__device__ __forceinline__ void hy_build_filter(const u32x4& raw) {
  const int tid = threadIdx.x;
  *(u32x4*)(g_lds + tid * 16) = raw;
  __syncthreads();
  u32x4 nx = (u32x4){0u, 0u, 0u, 0u};
  if (tid < 511) nx = *(const u32x4*)(g_lds + (tid + 1) * 16);
  const unsigned d[8] = {raw.x, raw.y, raw.z, raw.w, nx.x, nx.y, nx.z, nx.w};
#pragma unroll
  for (int r = 1; r < 8; ++r) {
    u32x4 o;
    if ((r & 1) == 0) { o.x = d[r / 2]; o.y = d[r / 2 + 1]; o.z = d[r / 2 + 2]; o.w = d[r / 2 + 3]; }
    else { const int a = (r - 1) / 2;
      o.x = __builtin_amdgcn_alignbit(d[a + 1], d[a], 16); o.y = __builtin_amdgcn_alignbit(d[a + 2], d[a + 1], 16);
      o.z = __builtin_amdgcn_alignbit(d[a + 3], d[a + 2], 16); o.w = __builtin_amdgcn_alignbit(d[a + 4], d[a + 3], 16); }
    *(u32x4*)(g_lds + r * HY_RSTRIDE + tid * 16) = o;
  }
}

__device__ __forceinline__ void hy_gate_raw(HyRaw (&raw)[16], const bf16_t* xp, int tl, int lane, int fq) {
  u32x2 mm[16];
#pragma unroll
  for (int tb = 0; tb < 16; ++tb) mm[tb] = *(const u32x2*)(xp + 16 * tb);
  unsigned short um0 = xp[tl > 0 ? -1 : 0]; if (tl == 0) um0 = 0;
  const int t15 = tl + 240;
  unsigned short up15 = (xp + 240)[t15 + 4 < SEQ ? 4 : 3]; if (t15 + 4 >= SEQ) up15 = 0;
#pragma unroll
  for (int tb = 0; tb < 16; ++tb) {
    const unsigned sl = (fq == 3 && tb > 0) ? mm[tb > 0 ? tb - 1 : 0].y : mm[tb].y;
    const unsigned lw = (unsigned)__shfl((int)sl, (lane + 48) & 63);
    unsigned short um = (unsigned short)(lw >> 16);
    if (tb == 0) um = (fq == 0) ? um0 : um;
    const unsigned sr = (fq == 0 && tb < 15) ? mm[tb < 15 ? tb + 1 : 15].x : mm[tb].x;
    const unsigned rw = (unsigned)__shfl((int)sr, (lane + 16) & 63);
    unsigned short up = (unsigned short)(rw & 0xffffu);
    if (tb == 15) up = (fq == 3) ? up15 : up;
    raw[tb].m = mm[tb]; raw[tb].um = um; raw[tb].up = up;
  }
}

__device__ __forceinline__ void hyena_phase(const Params& P, int bid, int G) {
  unsigned char* ws = P.ws; int tid = threadIdx.x; asm volatile("" : "+v"(tid)); const int lane = tid & 63, wave = __builtin_amdgcn_readfirstlane(tid >> 6);
  LAS unsigned char* lds = (LAS unsigned char*)g_lds;
  const bf16_t* uhyt = (const bf16_t*)(ws + OFF_UHYT);
  const bf16_t* hf = (const bf16_t*)(ws + OFF_HF);
  bf16_t* zhyT = (bf16_t*)(ws + OFF_ZS5);
  const float* cw = P.in[17]; const float* cb = P.in[18];
  const int fr = lane & 15, fq = lane >> 4;
  for (int c = bid; c < DHY; c += G) {
    const u32x4 f0raw = *(const u32x4*)(hf + (size_t)(0 * DHY + c) * 4096 + tid * 8);
    const u32x4 f1raw = *(const u32x4*)(hf + (size_t)(1 * DHY + c) * 4096 + tid * 8);
    __syncthreads();
#pragma unroll 1
    for (int half = 0; half < 2; ++half) {
      f32x4 v[8];
#pragma unroll
      for (int i = 0; i < 8; ++i) { const int task = tid + (half * 8 + i) * NT, b = task >> 9, t = (task & 511) * 4; v[i] = hy_conv4(uhyt, cw, cb, c, b, t); }
#pragma unroll
      for (int i = 0; i < 8; ++i) { const int task = tid + (half * 8 + i) * NT, b = task >> 9, t = (task & 511) * 4;
        u32x2 w; w.x = cvt_pk_bf16(v[i][0], v[i][1]); w.y = cvt_pk_bf16(v[i][2], v[i][3]);
        *(LAS u32x2*)(lds + HY_ZOFF + b * HY_ZSTRIDE + t * 2) = w; }
    }
    hy_build_filter(f0raw);
    __syncthreads();
    f32x4 acc[16];
    hy_toeplitz(acc, wave, lane);
    const float bias0 = P.in[27][c], bias1 = P.in[27][DHY + c];
    u32x2 z1[16];
    {
      const int chn = DHY + c;
      const float w0 = cw[chn], w1 = cw[3 * DHY + chn], w2 = cw[6 * DHY + chn], bb = cb[chn];
      const int tl = 256 * wave + 4 * fq;
      const bf16_t* xp = uhyt + ((size_t)chn * NB + fr) * SEQ + tl; asm volatile("" : "+v"(xp));
      HyRaw raw[16];
      hy_gate_raw(raw, xp, tl, lane, fq);
#pragma unroll
      for (int tb = 0; tb < 16; ++tb) {
        const int t = tl + 16 * tb;
        const u32x2 zv = *(LAS const u32x2*)(lds + HY_ZOFF + fr * HY_ZSTRIDE + t * 2);
        const f32x4 x1 = hy_conv_raw(raw[tb], w0, w1, w2, bb);
        z1[tb].x = cvt_pk_bf16(x1[0] * (acc[tb][0] + bias0 * bflo(zv.x)), x1[1] * (acc[tb][1] + bias0 * bfhi(zv.x)));
        z1[tb].y = cvt_pk_bf16(x1[2] * (acc[tb][2] + bias0 * bflo(zv.y)), x1[3] * (acc[tb][3] + bias0 * bfhi(zv.y)));
      }
    }
    __syncthreads();
#pragma unroll
    for (int tb = 0; tb < 16; ++tb) {
      const int t = 256 * wave + 16 * tb + 4 * fq;
      *(LAS u32x2*)(lds + HY_ZOFF + fr * HY_ZSTRIDE + t * 2) = z1[tb];
    }
    hy_build_filter(f1raw);
    __syncthreads();
    hy_toeplitz(acc, wave, lane);
    {
      const int chn = 2 * DHY + c;
      const float w0 = cw[chn], w1 = cw[3 * DHY + chn], w2 = cw[6 * DHY + chn], bb = cb[chn];
      const int tl = 256 * wave + 4 * fq;
      const bf16_t* xp = uhyt + ((size_t)chn * NB + fr) * SEQ + tl; asm volatile("" : "+v"(xp));
      bf16_t* zp = zhyT + ((size_t)c * NB + fr) * SEQ + tl; asm volatile("" : "+v"(zp));
      HyRaw raw[16];
      hy_gate_raw(raw, xp, tl, lane, fq);
#pragma unroll
      for (int tb = 0; tb < 16; ++tb) {
        const int t = tl + 16 * tb;
        const u32x2 zv = *(LAS const u32x2*)(lds + HY_ZOFF + fr * HY_ZSTRIDE + t * 2);
        const f32x4 x2 = hy_conv_raw(raw[tb], w0, w1, w2, bb);
        u32x2 w;
        w.x = cvt_pk_bf16(x2[0] * (acc[tb][0] + bias1 * bflo(zv.x)), x2[1] * (acc[tb][1] + bias1 * bfhi(zv.x)));
        w.y = cvt_pk_bf16(x2[2] * (acc[tb][2] + bias1 * bflo(zv.y)), x2[3] * (acc[tb][3] + bias1 * bfhi(zv.y)));
        *(u32x2*)(zp + 16 * tb) = w;
      }
    }
  }
  __syncthreads();
}

__device__ __forceinline__ void zhy_transpose(unsigned char* ws, int bid, int G) {
  int tid = threadIdx.x; asm volatile("" : "+v"(tid)); const int lane = tid & 63, wave = __builtin_amdgcn_readfirstlane(tid >> 6);
  LAS unsigned char* tl = (LAS unsigned char*)g_lds + wave * 9216;
  const bf16_t* zhyT = (const bf16_t*)(ws + OFF_ZS5);
  bf16_t* zhy = (bf16_t*)(ws + OFF_ZHY);
  const int r8 = lane >> 3, q8 = lane & 7;
  for (int tile = bid * 8 + wave; tile < 4096; tile += G * 8) {
    const int cb = tile & 7, tb = tile >> 3;
    u32x4 v[8];
#pragma unroll
    for (int i = 0; i < 8; ++i) v[i] = *(const u32x4*)(zhyT + (size_t)(cb * 64 + 8 * i + r8) * NTOK + tb * 64 + q8 * 8);
#pragma unroll
    for (int i = 0; i < 8; ++i) {
      const int cl = 8 * i + r8;
#pragma unroll
      for (int j = 0; j < 8; ++j) {
        const unsigned wv = v[i][j >> 1];
        *(LAS unsigned short*)(tl + (q8 * 8 + j) * 144 + cl * 2) = (unsigned short)((j & 1) ? (wv >> 16) : (wv & 0xffffu));
      }
    }
    asm volatile("s_waitcnt lgkmcnt(0)" ::: "memory");
#pragma unroll
    for (int i = 0; i < 8; ++i) {
      const int tokl = 8 * i + r8;
      const u32x4 o = *(LAS const u32x4*)(tl + tokl * 144 + q8 * 16);
      *(u32x4*)(zhy + (size_t)(tb * 64 + tokl) * DHY + cb * 64 + q8 * 8) = o;
    }
    asm volatile("s_waitcnt lgkmcnt(0)" ::: "memory");
  }
}

__device__ __forceinline__ void late_transposes(const Params& P, int bid, int G) {
  unsigned char* ws = P.ws; int tid = threadIdx.x; asm volatile("" : "+v"(tid)); const int lane = tid & 63, wave = __builtin_amdgcn_readfirstlane(tid >> 6);
  constexpr int I_GLU = (DS5 / 64) * (DS5 / 32), I_A = (DS5 / 64) * (DM / 32), I_B = I_A,
                I_OUT = (DM / 64) * (DM / 32), I_GU = (DM / 64) * (2 * DFF / 32), I_DN = (DFF / 64) * (DM / 32);
  constexpr int NITEMS = I_GLU + I_A + I_B + I_OUT + I_GU + I_DN;
  float* scr = (float*)(g_lds + wave * 9216);
  const int slot = (wave >= 4) ? (bid * 4 + (wave - 4)) * 2 : -1, nslot = G * 12;
  for (int rep = 0; rep < 3; ++rep) {
    int first;
    if (wave >= 4) { if (rep == 2) break; first = (bid * 4 + (wave - 4)) * 2 + rep; } else { if (rep > 0) break; first = G * 8 + bid * 4 + wave; }
    for (int it = first; it < NITEMS; it += nslot) {
      int r = it;
      if (r < I_GLU) { transpose_item(P.in[15], DS5, DS5, (bf16_t*)(ws + OFF_WGLU), r, 0, scr, lane); continue; } r -= I_GLU;
      if (r < I_A) { transpose_item(P.in[28], DS5, DM, (bf16_t*)(ws + OFF_WA), r, 0, scr, lane); continue; } r -= I_A;
      if (r < I_B) { transpose_item(P.in[29], DHY, DM, (bf16_t*)(ws + OFF_WB), r, 0, scr, lane); continue; } r -= I_B;
      if (r < I_OUT) { transpose_item(P.in[30], DM, DM, (bf16_t*)(ws + OFF_WOUT), r, 0, scr, lane); continue; } r -= I_OUT;
      if (r < I_GU) { transpose_item(P.in[31], DM, 2 * DFF, (bf16_t*)(ws + OFF_WGU), r, 1, scr, lane); continue; } r -= I_GU;
      transpose_item(P.in[32], DFF, DM, (bf16_t*)(ws + OFF_WDOWN), r, 0, scr, lane);
    }
  }
  (void)slot;
}

#define XB_TMO      128
#define XB_XCNT(j)  (256  + 64 * (j))
#define XB_XSUB(j)  (1280 + 64 * (j))
#define XB_XGEN(j)  (2304 + 64 * (j))
#define XB_TOP      3328
#define XB_TOPGEN   3392
#define XCD_BAR_WORDS 3456
#define XB_SPIN_CAP (1u << 18)
__device__ __forceinline__ unsigned xb_ld(unsigned* p)              { return __hip_atomic_load(p, __ATOMIC_RELAXED, __HIP_MEMORY_SCOPE_AGENT); }
__device__ __forceinline__ unsigned xb_add(unsigned* p, unsigned v) { return __hip_atomic_fetch_add(p, v, __ATOMIC_RELAXED, __HIP_MEMORY_SCOPE_AGENT); }
__device__ __forceinline__ unsigned xb_xcc_id() { return (unsigned)__builtin_amdgcn_s_getreg((3 << 11) | 20) & 0xFu; }
#define XB_SPIN(cond, bar) do { unsigned _sp = 0; while (cond) { __builtin_amdgcn_s_sleep(1); \
    if ((++_sp & 255u) == 0u) { if (xb_ld(&(bar)[XB_TMO])) break; if (_sp > XB_SPIN_CAP) { atomicAdd(&(bar)[XB_TMO], 1u); break; } } } } while (0)
struct XcdBarrier { unsigned* bar; unsigned x; volatile LAS unsigned* st; };
__device__ __forceinline__ XcdBarrier xcd_barrier_post(unsigned* bar, volatile LAS unsigned* st) {
  XcdBarrier b; b.bar = bar; b.x = xb_xcc_id(); b.st = st;
  if (threadIdx.x == 0) (void)xb_add(&bar[XB_XCNT(b.x)], 1u);
  return b;
}
__device__ __forceinline__ void xcd_barrier_complete(unsigned* bar, unsigned x, unsigned& nloc, unsigned& nx) {
  const unsigned G = gridDim.x * gridDim.y * gridDim.z;
  unsigned sum, cnt, mine, sp = 0u;
  for (;;) {
    sum = 0u; cnt = 0u; mine = 0u;
#pragma unroll
    for (unsigned j = 0; j < 16; ++j) { const unsigned c = xb_ld(&bar[XB_XCNT(j)]); sum += c; cnt += (c > 0u) ? 1u : 0u; mine = (j == x) ? c : mine; }
    if (sum == G) break;
    __builtin_amdgcn_s_sleep(1);
    if ((++sp & 255u) == 0u) { if (xb_ld(&bar[XB_TMO])) break; if (sp > XB_SPIN_CAP) { atomicAdd(&bar[XB_TMO], 1u); break; } }
  }
  nloc = mine > 0u ? mine : 1u; nx = cnt > 0u ? cnt : 1u;
}
__device__ __forceinline__ void xcd_barrier(const XcdBarrier& b) {
  asm volatile("s_waitcnt vmcnt(0)" ::: "memory");
  __syncthreads();
  if (threadIdx.x == 0) {
    unsigned* bar = b.bar;
    __builtin_amdgcn_s_waitcnt(0);
    unsigned nloc = b.st[0], nx = b.st[1];
    if (nloc == 0u) { xcd_barrier_complete(bar, b.x, nloc, nx); b.st[0] = nloc; b.st[1] = nx; }
    const unsigned old = xb_add(&bar[XB_XSUB(b.x)], 1u);
    const unsigned gen = old / nloc;
    if (old + 1u == (gen + 1u) * nloc) {
      __builtin_amdgcn_fence(__ATOMIC_RELEASE, "agent");
      asm volatile("s_waitcnt vmcnt(0)" ::: "memory");
      const unsigned og = xb_add(&bar[XB_TOP], 1u);
      const unsigned tg = og / nx;
      if (og + 1u == (tg + 1u) * nx) xb_add(&bar[XB_TOPGEN], 1u);
      else XB_SPIN(xb_ld(&bar[XB_TOPGEN]) == tg, bar);
      __builtin_amdgcn_fence(__ATOMIC_ACQUIRE, "agent");
      xb_add(&bar[XB_XGEN(b.x)], 1u);
      asm volatile("s_waitcnt vmcnt(0)" ::: "memory");
    } else {
      XB_SPIN(xb_ld(&bar[XB_XGEN(b.x)]) == gen, bar);
      __builtin_amdgcn_fence(__ATOMIC_ACQUIRE, "agent");
      asm volatile("s_waitcnt vmcnt(0)" ::: "memory");
    }
  }
  __syncthreads();
}

__global__ void __launch_bounds__(NT) mega(Params P) {
  cg::grid_group grid = cg::this_grid();
  unsigned char* ws = P.ws;
  const int G = gridDim.x, bid = blockIdx.x;
  const float* mod = (const float*)(ws + OFF_MOD);

  volatile LAS unsigned* xst = (volatile LAS unsigned*)((LAS unsigned char*)g_lds + LDS_BYTES - 16);
  if (threadIdx.x == 0) { xst[0] = 0u; xst[1] = 0u; }
  __syncthreads();
  XcdBarrier xb = xcd_barrier_post((unsigned*)(ws + OFF_BAR), xst);
  phase0(P, bid, G);
  grid.sync();
  phase1(P, bid, G);
  xcd_barrier(xb);
  { EpiIn e{(bf16_t*)(ws + OFF_UEXT), (bf16_t*)(ws + OFF_UHYT), (bf16_t*)(ws + OFF_GATE)};
    SchedGrid sc{(const char*)(ws + OFF_H1), (const char*)(ws + OFF_WIN), DM, DM, NTOK / BM, DIN / BM, G, bid};
    gemm_phase(DM, DM, DM, sc, e); }
  xcd_barrier(xb);
  { EpiS5E e{(float*)(ws + OFF_E)};
    SchedGrouped sc{(const char*)(ws + OFF_UEXT), (const char*)(ws + OFF_PCAT), UEXT_LD, 512, 1, S5G * 4, G, bid};
    gemm_phase(UEXT_LD, 512, 512, sc, e); }
  hyena_phase(P, bid, G);
  xcd_barrier(xb);
  s5_carry(P, bid, G);
  zhy_transpose(ws, bid, G);
  late_transposes(P, bid, G);
  xcd_barrier(xb);
  { EpiS5Out e{(bf16_t*)(ws + OFF_ZS5)};
    SchedGrouped sc{(const char*)(ws + OFF_UEXT), (const char*)(ws + OFF_MCAT), UEXT_LD, UEXT_LD, 2, S5G * 8, G, bid};
    gemm_phase(UEXT_LD, UEXT_LD, UEXT_LD, sc, e); }
  xcd_barrier(xb);
  { EpiGlu e{(const bf16_t*)(ws + OFF_ZS5), P.in[16], (bf16_t*)(ws + OFF_ZG)};
    SchedGrid sc{(const char*)(ws + OFF_ZS5), (const char*)(ws + OFF_WGLU), DS5, DS5, NTOK / BM, DS5 / BM, G, bid};
    gemm_phase(DS5, DS5, DS5, sc, e); }
  xcd_barrier(xb);
  { EpiMerge e{(const bf16_t*)(ws + OFF_GATE), (bf16_t*)(ws + OFF_MERGED)};
    SchedPair sc{(const char*)(ws + OFF_ZG), (const char*)(ws + OFF_WA), (const char*)(ws + OFF_ZHY), (const char*)(ws + OFF_WB), DS5, DS5, NTOK / BM, DM / BM, G, bid};
    gemm_phase(DS5, DS5, DS5, sc, e); }
  xcd_barrier(xb);
  { EpiResid<false> e{P.in[0], mod + 2 * DM, (bf16_t*)(ws + OFF_X1B)};
    SchedGrid sc{(const char*)(ws + OFF_MERGED), (const char*)(ws + OFF_WOUT), DM, DM, NTOK / BM, DM / BM, G, bid};
    gemm_phase(DM, DM, DM, sc, e); }
  xcd_barrier(xb);
  norm_mod_rows<true>(ws + OFF_X1B, P.in[5], mod, 3 * DM, 4 * DM, (bf16_t*)(ws + OFF_H1), bid, G);
  xcd_barrier(xb);
  { EpiGU e{(bf16_t*)(ws + OFF_ACT)};
    SchedGrid sc{(const char*)(ws + OFF_H1), (const char*)(ws + OFF_WGU), DM, DM, NTOK / BM, 2 * DFF / BM, G, bid};
    gemm_phase(DM, DM, DM, sc, e); }
  xcd_barrier(xb);
  { EpiResid<true> e{ws + OFF_X1B, mod + 5 * DM, (bf16_t*)(ws + OFF_X2B)};
    SchedGrid sc{(const char*)(ws + OFF_ACT), (const char*)(ws + OFF_WDOWN), DFF, DFF, NTOK / BM, DM / BM, G, bid};
    gemm_phase(DFF, DFF, DFF, sc, e); }
  xcd_barrier(xb);
  { const int lane = threadIdx.x & 63, wave = threadIdx.x >> 6;
    for (int row0 = (bid * 8 + wave) * 2; row0 < NTOK; row0 += G * 16) {
      f32x4 v[2][4]; float s[2] = {0.f, 0.f};
#pragma unroll
      for (int r = 0; r < 2; ++r) {
        const u32x2* xr = (const u32x2*)((const bf16_t*)(ws + OFF_X2B) + (size_t)(row0 + r) * DM) + lane;
#pragma unroll
        for (int j = 0; j < 4; ++j) { const u32x2 w = __builtin_nontemporal_load(&xr[64 * j]); v[r][j] = (f32x4){bflo(w.x), bfhi(w.x), bflo(w.y), bfhi(w.y)};
          s[r] += (v[r][j][0] * v[r][j][0] + v[r][j][1] * v[r][j][1]) + (v[r][j][2] * v[r][j][2] + v[r][j][3] * v[r][j][3]); }
      }
#pragma unroll
      for (int r = 0; r < 2; ++r) {
        const float rstd = 1.f / sqrtf(wave_sum(s[r]) * (1.f / DM) + 1e-6f);
        f32x4* orow = (f32x4*)(P.out + (size_t)(row0 + r) * DM) + lane;
#pragma unroll
        for (int j = 0; j < 4; ++j) { const f32x4 gg = ((const f32x4*)P.in[33])[lane + 64 * j]; __builtin_nontemporal_store(v[r][j] * rstd * gg, &orow[64 * j]); }
      }
    } }
}

extern "C" void kernel_launch(void* const* d_in, const int* in_sizes, int n_in, void* d_out, int out_size,
                              void* d_ws, size_t ws_size, hipStream_t stream) {
  static int grid_blocks = 0;
  if (!grid_blocks) {
    int dev = 0, cus = 0, per_cu = 0;
    (void)hipGetDevice(&dev);
    (void)hipDeviceGetAttribute(&cus, hipDeviceAttributeMultiprocessorCount, dev);
    (void)hipFuncSetAttribute((const void*)mega, hipFuncAttributeMaxDynamicSharedMemorySize, LDS_BYTES);
    (void)hipOccupancyMaxActiveBlocksPerMultiprocessor(&per_cu, (const void*)mega, NT, LDS_BYTES);
    if (per_cu < 1) { fprintf(stderr, "kernel_launch: occupancy query says %d blocks/CU\n", per_cu); per_cu = 1; }
    grid_blocks = cus;
    if (n_in != 34 || out_size != NTOK * DM || ws_size < WS_END)
      fprintf(stderr, "kernel_launch: unexpected sizes n_in %d out %d ws %zu (need %zu)\n", n_in, out_size, ws_size, (size_t)WS_END);
  }
  (void)hipMemsetAsync((unsigned char*)d_ws + OFF_BAR, 0, XCD_BAR_WORDS * 4, stream);
  Params p{};
  for (int i = 0; i < 34; ++i) p.in[i] = (const float*)d_in[i];
  p.out = (float*)d_out; p.ws = (unsigned char*)d_ws;
  void* args[] = {&p};
  hipError_t e = hipLaunchCooperativeKernel((void*)mega, dim3(grid_blocks), dim3(NT), args, LDS_BYTES, stream);
  if (e != hipSuccess) fprintf(stderr, "cooperative launch failed: %s (grid %d)\n", hipGetErrorString(e), grid_blocks);
}
```

```cpp
#include <hip/hip_runtime.h>
#include <hip/hip_cooperative_groups.h>
#include <cstdio>
#include <cstdint>
namespace cg = cooperative_groups;

typedef unsigned short bf16_t;
typedef short bf16x8 __attribute__((ext_vector_type(8)));
typedef float f32x4 __attribute__((ext_vector_type(4)));
typedef unsigned u32x4 __attribute__((ext_vector_type(4)));
typedef unsigned u32x2 __attribute__((ext_vector_type(2)));

constexpr int DM = 1024, NB = 16, SEQ = 2048, NTOK = NB * SEQ, DS5 = 512, DHY = 512, DIN = 4096, DFF = 2816;
constexpr int S5G = 32, S5P = 64, S5C = 16, CT = 32, NCH = SEQ / CT;
constexpr int UEXT_LD = 768;
constexpr int NT = 512;

constexpr size_t al256(size_t x) { return (x + 255) & ~(size_t)255; }
constexpr size_t OFF_MOD   = 0;
constexpr size_t OFF_WIN   = al256(OFF_MOD + (size_t)NB * 6 * DM * 4);
constexpr size_t OFF_WGLU  = al256(OFF_WIN + (size_t)DIN * DM * 2);
constexpr size_t OFF_WA    = al256(OFF_WGLU + (size_t)DS5 * DS5 * 2);
constexpr size_t OFF_WB    = al256(OFF_WA + (size_t)DM * DS5 * 2);
constexpr size_t OFF_WOUT  = al256(OFF_WB + (size_t)DM * DHY * 2);
constexpr size_t OFF_WGU   = al256(OFF_WOUT + (size_t)DM * DM * 2);
constexpr size_t OFF_WDOWN = al256(OFF_WGU + (size_t)2 * DFF * DM * 2);
constexpr size_t OFF_KTAB  = al256(OFF_WDOWN + (size_t)DM * DFF * 2);
constexpr size_t OFF_MCAT  = al256(OFF_KTAB + (size_t)2 * S5G * CT * 256 * 4);
constexpr size_t OFF_PCAT  = al256(OFF_MCAT + (size_t)S5G * 512 * UEXT_LD * 2);
constexpr size_t OFF_H2TAB = al256(OFF_PCAT + (size_t)S5G * 256 * 512 * 2);
constexpr size_t OFF_PW    = al256(OFF_H2TAB + (size_t)SEQ * 64 * 4);
constexpr size_t OFF_CF    = al256(OFF_PW + (size_t)64 * 33 * 64 * 8);
constexpr size_t OFF_HF    = al256(OFF_CF + (size_t)64 * 64 * 8);
constexpr size_t OFF_H1    = al256(OFF_HF + (size_t)2 * DHY * 4096 * 2);
constexpr size_t OFF_UEXT  = al256(OFF_H1 + (size_t)NTOK * DM * 2);
constexpr size_t OFF_UHYT  = al256(OFF_UEXT + (size_t)S5G * 1024 * UEXT_LD * 2);
constexpr size_t OFF_GATE  = al256(OFF_UHYT + (size_t)3 * DHY * NB * SEQ * 2);
constexpr size_t OFF_E     = al256(OFF_GATE + (size_t)NTOK * 2 * DM * 2);
constexpr size_t OFF_ZHY   = al256(OFF_E + (size_t)S5G * 1024 * 256 * 4);
constexpr size_t OFF_BAR   = al256(OFF_ZHY + (size_t)NTOK * DHY * 2);
constexpr size_t WS_END    = al256(OFF_BAR + (size_t)3456 * 4);
constexpr size_t OFF_ZS5   = OFF_H1;
constexpr size_t OFF_ZG    = OFF_H1 + (size_t)NTOK * DS5 * 2;
constexpr size_t OFF_MERGED = OFF_UHYT;
constexpr size_t OFF_ACT   = OFF_UHYT;
constexpr size_t OFF_X1B   = OFF_E;
constexpr size_t OFF_X2B   = OFF_H1;
static_assert(OFF_X1B + (size_t)NTOK * DM * 2 <= OFF_BAR, "x1b overlay");
static_assert((size_t)NTOK * DFF * 2 <= OFF_E - OFF_UHYT, "act overlay");

constexpr int LDS_BYTES = 135168;

struct Params {
  const float* in[34];
  float* out;
  unsigned char* ws;
};

extern __shared__ __attribute__((aligned(16))) unsigned char g_lds[];

typedef float f32x2_ __attribute__((ext_vector_type(2)));
typedef __bf16 bf16x2_ __attribute__((ext_vector_type(2)));
__device__ __forceinline__ unsigned cvt_pk_bf16(float lo, float hi) { const f32x2_ v = {lo, hi}; return __builtin_bit_cast(unsigned, __builtin_convertvector(v, bf16x2_)); }
__device__ __forceinline__ bf16_t f2bf(float f) { return (bf16_t)(cvt_pk_bf16(f, 0.f) & 0xffffu); }
__device__ __forceinline__ float bf2f(unsigned h) { return __uint_as_float(h << 16); }
__device__ __forceinline__ float bflo(unsigned w) { return __uint_as_float(w << 16); }
__device__ __forceinline__ float bfhi(unsigned w) { return __uint_as_float(w & 0xffff0000u); }
__device__ __forceinline__ float sigmoidf_(float x) { return __builtin_amdgcn_rcpf(1.f + __expf(-x)); }
__device__ __forceinline__ float siluf_(float x) { return x * __builtin_amdgcn_rcpf(1.f + __expf(-x)); }
__device__ __forceinline__ float gelu_tanh(float x) {
  const float u = 0.7978845608028654f * (x + 0.044715f * x * x * x);
  return x * __builtin_amdgcn_rcpf(1.f + __expf(-2.f * u));
}
__device__ __forceinline__ float wave_sum(float v) {
#pragma unroll
  for (int o = 1; o < 64; o <<= 1) v += __shfl_xor(v, o);
  return v;
}
__device__ __forceinline__ void sincos_red(double ang, float& s, float& c) {
  const double r = ang - 6.283185307179586476925 * floor(ang * 0.159154943091895335769);
  const float rf = (float)r;
  s = sinf(rf); c = cosf(rf);
}
struct S5Disc { float rho, th, cfr, cfi; };
__device__ __forceinline__ S5Disc s5_disc(const Params& P, int d, int g, int p) {
  const float lr = P.in[7][(d * S5G + g) * S5P + p], li = P.in[8][(d * S5G + g) * S5P + p];
  const float step = expf(P.in[9][d * S5G + g]);
  S5Disc r; r.rho = lr * step; r.th = li * step;
  float s, c; sincos_red((double)r.th, s, c);
  const float mag = expf(r.rho), are = mag * c, aim = mag * s, nr = are - 1.f, den = lr * lr + li * li;
  r.cfr = (nr * lr + aim * li) / den; r.cfi = (aim * lr - nr * li) / den;
  return r;
}
__device__ __forceinline__ void s5_pow(const S5Disc& dsc, int k, float& pr, float& pi) {
  float s, c; sincos_red((double)dsc.th * (double)k, s, c);
  const float m = expf(dsc.rho * (float)k);
  pr = m * c; pi = m * s;
}

constexpr int BM = 256, BK = 64, HALF = 128, HT = HALF * BK;
__device__ __forceinline__ int lds_byte(int r, int c) {
  int st = (r >> 4) * 2 + (c >> 5), rr = r & 15, cc = c & 31, ob = rr * 64 + cc * 2;
  return st * 1024 + (ob ^ (((ob >> 9) & 1) << 5));
}
__device__ __forceinline__ void stage_rc(int b, int& R, int& C) {
  int st = b / 1024, sb = b % 1024, swz = sb ^ (((sb >> 9) & 1) << 5);
  R = (st >> 1) * 16 + swz / 64; C = (st & 1) * 32 + (swz % 64) / 2;
}

__device__ __forceinline__ int perm32(int rho) { const int n = rho >> 4, i = rho & 15; return 8 * (i >> 2) + 4 * n + (i & 3); }
#define LAS __attribute__((address_space(3)))
struct Unit { const char* A; const char* B; int r0, c0, aux; };
template <class Sched, class Epi>
__device__ __forceinline__ void gemm_phase(const int lda, const int ldb, const int K, const Sched& S, const Epi& E) {
  LAS unsigned char* lds = (LAS unsigned char*)g_lds;
  int tid = threadIdx.x; asm volatile("" : "+v"(tid));
  const int wid = __builtin_amdgcn_readfirstlane(tid >> 6), lane = tid & 63, wr = wid >> 2, wc = wid & 3, fr = lane & 15, fq = lane >> 4;
  const int nt = K / BK;
  unsigned voffA[2], voffB[2];
#pragma unroll
  for (int i = 0; i < 2; ++i) { int R, C; stage_rc(tid * 16 + i * 8192, R, C); const int Rb = (R & ~31) + perm32(R & 31);
    voffA[i] = (unsigned)(R * lda + C) * 2u; voffB[i] = (unsigned)(Rb * ldb + C) * 2u; }
  const size_t kstep = (size_t)(BK * 2);
  const size_t hstepA = (size_t)HALF * lda * 2, hstepB = (size_t)HALF * ldb * 2;
  const unsigned ldsw = (unsigned)wid * 1024u;
  const int aoff = lds_byte(wr * 64 + fr, fq * 8), boff = lds_byte(wc * 32 + fr, fq * 8);
  constexpr int HTB = HALF * BK * 2;
#define G_SA(b, h) (((b) * 2 + (h)) * HTB)
#define G_SB(b, h) ((4 + (b) * 2 + (h)) * HTB)
#define G_STAGE(bufoff, gbase, voff) do { _Pragma("unroll") for (int _i = 0; _i < 2; ++_i) \
    __builtin_amdgcn_global_load_lds((const unsigned*)((const char*)(gbase) + (voff)[_i]), (LAS unsigned*)(lds + (bufoff) + ldsw + _i * 8192), 16, 0, 0); } while (0)
#define G_LDA(dst, b, h) do { _Pragma("unroll") for (int m = 0; m < 4; ++m) _Pragma("unroll") for (int k = 0; k < 2; ++k) dst[m][k] = *(const LAS bf16x8*)(lds + G_SA(b, h) + aoff + m * 2048 + k * 1024); } while (0)
#define G_LDB(dst, b, h) do { _Pragma("unroll") for (int n = 0; n < 2; ++n) _Pragma("unroll") for (int k = 0; k < 2; ++k) dst[n][k] = *(const LAS bf16x8*)(lds + G_SB(b, h) + boff + n * 2048 + k * 1024); } while (0)
#define G_MMA(ai, bj, At_, Bt_) do { __builtin_amdgcn_s_setprio(1); _Pragma("unroll") for (int m = 0; m < 4; ++m) _Pragma("unroll") for (int n = 0; n < 2; ++n) _Pragma("unroll") for (int k = 0; k < 2; ++k) \
    acc[ai][bj][m][n] = __builtin_amdgcn_mfma_f32_16x16x32_bf16(Bt_[n][k], At_[m][k], acc[ai][bj][m][n], 0, 0, 0); __builtin_amdgcn_s_setprio(0); } while (0)
#define G_WAIT_V(n) asm volatile("s_waitcnt vmcnt(" #n ")" ::: "memory")
#define G_WAIT_L(n) asm volatile("s_waitcnt lgkmcnt(" #n ")" ::: "memory")
#define G_BAR __builtin_amdgcn_s_barrier()
#define G_SCHED __builtin_amdgcn_sched_barrier(0)
  Unit cur, nxt; int ui = 0;
  if (!S.next(0, cur)) return;
  f32x4 acc[2][2][4][2];
#pragma unroll
  for (int a = 0; a < 2; ++a)
#pragma unroll
    for (int b = 0; b < 2; ++b)
#pragma unroll
      for (int m = 0; m < 4; ++m)
#pragma unroll
        for (int n = 0; n < 2; ++n) acc[a][b][m][n] = (f32x4){0.f, 0.f, 0.f, 0.f};
  bf16x8 At[4][2], B0[2][2], B1[2][2];
  const char* cA = cur.A; const char* cB = cur.B;
  G_STAGE(G_SB(0, 0), cB, voffB); G_STAGE(G_SB(0, 1), cB + hstepB, voffB); G_STAGE(G_SA(0, 0), cA, voffA); G_STAGE(G_SA(0, 1), cA + hstepA, voffA);
  if (wr == 1) G_BAR;
  G_WAIT_V(2); G_BAR;
  G_STAGE(G_SB(1, 0), cB + kstep, voffB); G_STAGE(G_SA(1, 0), cA + kstep, voffA); G_STAGE(G_SB(1, 1), cB + hstepB + kstep, voffB);
  G_WAIT_V(6); G_BAR;
  for (;;) {
    const bool has_next = S.next(ui + 1, nxt);
    const char* nA = has_next ? nxt.A : cA; const char* nB = has_next ? nxt.B : cB;
    for (int t = 0; t < nt; t += 2) {
      const bool last = (t == nt - 2);
      const char* a1 = cA + (size_t)(t + 1) * kstep;
      const char* a2 = last ? nA : cA + (size_t)(t + 2) * kstep; const char* b2 = last ? nB : cB + (size_t)(t + 2) * kstep;
      const char* a3 = a2 + kstep; const char* b3 = b2 + kstep;
      G_LDB(B0, 0, 0); G_LDB(B1, 0, 1); G_SCHED; G_LDA(At, 0, 0); G_STAGE(G_SA(1, 1), a1 + hstepA, voffA);
      G_WAIT_V(8); G_WAIT_L(0); G_BAR; G_MMA(0, 0, At, B0); G_MMA(0, 1, At, B1); G_BAR; G_SCHED;
      G_LDA(At, 0, 1); G_STAGE(G_SB(0, 0), b2, voffB); G_STAGE(G_SB(0, 1), b2 + hstepB, voffB); G_STAGE(G_SA(0, 0), a2, voffA);
      G_WAIT_V(8); G_WAIT_L(0); G_BAR; G_MMA(1, 0, At, B0); G_MMA(1, 1, At, B1); G_BAR; G_SCHED;
      G_LDB(B0, 1, 0); G_LDB(B1, 1, 1); G_SCHED; G_LDA(At, 1, 0); G_STAGE(G_SA(0, 1), a2 + hstepA, voffA);
      G_WAIT_V(8); G_WAIT_L(0); G_BAR; G_MMA(0, 0, At, B0); G_MMA(0, 1, At, B1); G_BAR; G_SCHED;
      G_LDA(At, 1, 1); G_STAGE(G_SB(1, 0), b3, voffB); G_STAGE(G_SB(1, 1), b3 + hstepB, voffB); G_STAGE(G_SA(1, 0), a3, voffA);
      G_WAIT_V(8); G_WAIT_L(0); G_BAR; G_MMA(1, 0, At, B0); G_MMA(1, 1, At, B1); G_BAR; G_SCHED;
    }
    if (wr == 0) G_BAR;
    if constexpr (Epi::PAIRED) {
#pragma unroll
      for (int ai = 0; ai < 2; ++ai)
#pragma unroll
        for (int m = 0; m < 4; ++m)
          E.store_pair(cur, cur.r0 + ai * HALF + wr * 64 + m * 16 + fr, cur.c0 + wc * 32 + 8 * fq, acc[ai][0][m][0], acc[ai][0][m][1], acc[ai][1][m][0], acc[ai][1][m][1]);
    } else {
      typename Epi::Col cp[2];
#pragma unroll
      for (int bj = 0; bj < 2; ++bj) cp[bj] = E.col_prep(cur, cur.c0 + bj * HALF + wc * 32 + 8 * fq);
#pragma unroll
      for (int ai = 0; ai < 2; ++ai) {
        typename Epi::Aux ax[4][2];
#pragma unroll
        for (int m = 0; m < 4; ++m)
#pragma unroll
          for (int bj = 0; bj < 2; ++bj)
            ax[m][bj] = E.load(cur, cur.r0 + ai * HALF + wr * 64 + m * 16 + fr, cur.c0 + bj * HALF + wc * 32 + 8 * fq);
#pragma unroll
        for (int m = 0; m < 4; ++m)
#pragma unroll
          for (int bj = 0; bj < 2; ++bj)
            E.store(cur, cur.r0 + ai * HALF + wr * 64 + m * 16 + fr, cur.c0 + bj * HALF + wc * 32 + 8 * fq, acc[ai][bj][m][0], acc[ai][bj][m][1], cp[bj], ax[m][bj]);
      }
    }
    if (!has_next) break;
    if (!E.keep_acc(cur)) {
#pragma unroll
      for (int a = 0; a < 2; ++a)
#pragma unroll
        for (int b = 0; b < 2; ++b)
#pragma unroll
          for (int m = 0; m < 4; ++m)
#pragma unroll
            for (int n = 0; n < 2; ++n) acc[a][b][m][n] = (f32x4){0.f, 0.f, 0.f, 0.f};
    }
    cur = nxt; cA = nA; cB = nB; ++ui;
    if (wr == 1) G_BAR;
  }
  G_WAIT_V(0);
  G_BAR;
#undef G_SA
#undef G_SB
#undef G_STAGE
#undef G_LDA
#undef G_LDB
#undef G_MMA
}

struct SchedGrid {
  const char* A; const char* B; int lda, ldb, nM, nN, G, c;
  __device__ __forceinline__ bool next(int i, Unit& u) const {
    const int nwg = nM * nN; const long L = (long)i * G + c; if (L >= nwg) return false;
    int wgid = (int)L; { const int q = nwg / 8, r = nwg % 8, xcd = wgid % 8, off = wgid / 8; wgid = (xcd < r ? xcd * (q + 1) : r * (q + 1) + (xcd - r) * q) + off; }
    const int nig = 8 * nN, gid = wgid / nig, fm = gid * 8, gsz = (nM - fm) < 8 ? (nM - fm) : 8;
    const int pm = fm + ((wgid % nig) % gsz), pn = (wgid % nig) / gsz;
    u.r0 = pm * BM; u.c0 = pn * BM; u.aux = 0;
    u.A = A + (size_t)u.r0 * lda * 2; u.B = B + (size_t)u.c0 * ldb * 2; return true;
  }
};
struct SchedGrouped {
  const char* A; const char* B; int lda, ldb, nN, nunits, G, c;
  __device__ __forceinline__ bool next(int i, Unit& u) const {
    const int L = i * G + c; if (L >= nunits) return false;
    const int tn = L % nN, tm = (L / nN) & 3, g = L / (nN * 4);
    u.r0 = tm * BM; u.c0 = tn * BM; u.aux = g;
    u.A = A + ((size_t)g * 1024 + u.r0) * lda * 2; u.B = B + ((size_t)g * nN * BM + u.c0) * ldb * 2; return true;
  }
};
struct SchedPair {
  const char* A0; const char* B0; const char* A1; const char* B1; int lda, ldb, nM, nN, G, c;
  __device__ __forceinline__ bool next(int i, Unit& u) const {
    const int nwg = nM * nN; const long L = (long)(i >> 1) * G + c; if (L >= nwg) return false;
    int wgid = (int)L; { const int q = nwg / 8, r = nwg % 8, xcd = wgid % 8, off = wgid / 8; wgid = (xcd < r ? xcd * (q + 1) : r * (q + 1) + (xcd - r) * q) + off; }
    const int nig = 8 * nN, gid = wgid / nig, fm = gid * 8, gsz = (nM - fm) < 8 ? (nM - fm) : 8;
    const int pm = fm + ((wgid % nig) % gsz), pn = (wgid % nig) / gsz;
    u.r0 = pm * BM; u.c0 = pn * BM; u.aux = i & 1;
    u.A = ((i & 1) ? A1 : A0) + (size_t)u.r0 * lda * 2; u.B = ((i & 1) ? B1 : B0) + (size_t)u.c0 * ldb * 2; return true;
  }
};

struct NoAux {};
struct F8 { f32x4 a, b; };
__device__ __forceinline__ u32x4 pack8(const f32x4& a, const f32x4& b) { u32x4 w; w.x = cvt_pk_bf16(a[0], a[1]); w.y = cvt_pk_bf16(a[2], a[3]); w.z = cvt_pk_bf16(b[0], b[1]); w.w = cvt_pk_bf16(b[2], b[3]); return w; }
__device__ __forceinline__ F8 unpack8(const u32x4& w) { F8 r; r.a = (f32x4){bflo(w.x), bfhi(w.x), bflo(w.y), bfhi(w.y)}; r.b = (f32x4){bflo(w.z), bfhi(w.z), bflo(w.w), bfhi(w.w)}; return r; }
struct EpiIn {
  typedef NoAux Col; typedef NoAux Aux;
  static constexpr bool PAIRED = false;
  __device__ __forceinline__ bool keep_acc(const Unit&) const { return false; }
  bf16_t* uext; bf16_t* uhyt; bf16_t* gate;
  __device__ __forceinline__ Col col_prep(const Unit&, int) const { return Col{}; }
  __device__ __forceinline__ Aux load(const Unit&, int, int) const { return Aux{}; }
  __device__ __forceinline__ void store(const Unit& un, int row, int col, f32x4& v0, f32x4& v1, const Col&, const Aux&) const {
    const int b = row >> 11, tt = row & 2047;
    if (col < DS5) {
      const int g = col >> 4, cc = col & 15, ch = tt >> 5, s = tt & 31;
      *(u32x4*)(uext + ((size_t)(g * 1024 + b * NCH + ch)) * UEXT_LD + s * 16 + cc) = pack8(v0, v1);
    } else if (col < DS5 + 3 * DHY) {
      const int chn = col - DS5;
      bf16_t* p = uhyt + ((size_t)chn * NB + b) * SEQ + tt;
#pragma unroll
      for (int j = 0; j < 4; ++j) { p[(size_t)j * NB * SEQ] = f2bf(v0[j]); p[(size_t)(4 + j) * NB * SEQ] = f2bf(v1[j]); }
    } else {
      f32x4 s0, s1;
#pragma unroll
      for (int j = 0; j < 4; ++j) { s0[j] = sigmoidf_(v0[j]); s1[j] = sigmoidf_(v1[j]); }
      __builtin_nontemporal_store(pack8(s0, s1), (u32x4*)(gate + (size_t)row * (2 * DM) + (col - DS5 - 3 * DHY)));
    }
  }
};
struct EpiS5E {
  typedef NoAux Col; typedef NoAux Aux;
  static constexpr bool PAIRED = false;
  __device__ __forceinline__ bool keep_acc(const Unit&) const { return false; }
  float* E;
  __device__ __forceinline__ Col col_prep(const Unit&, int) const { return Col{}; }
  __device__ __forceinline__ Aux load(const Unit&, int, int) const { return Aux{}; }
  __device__ __forceinline__ void store(const Unit& un, int row, int col, f32x4& v0, f32x4& v1, const Col&, const Aux&) const {
    float* p = E + ((size_t)un.aux * 1024 + row) * 256 + col; *(f32x4*)p = v0; *(f32x4*)(p + 4) = v1; }
};
struct EpiS5Out {
  typedef NoAux Col; typedef NoAux Aux;
  static constexpr bool PAIRED = false;
  __device__ __forceinline__ bool keep_acc(const Unit&) const { return false; }
  bf16_t* zs5;
  __device__ __forceinline__ Col col_prep(const Unit&, int) const { return Col{}; }
  __device__ __forceinline__ Aux load(const Unit&, int, int) const { return Aux{}; }
  __device__ __forceinline__ void store(const Unit& un, int row, int col, f32x4& v0, f32x4& v1, const Col&, const Aux&) const {
    const int b = row >> 6, ch = row & 63, t = col >> 4, cc = col & 15, g = un.aux;
    const size_t tok = (size_t)b * SEQ + ch * CT + t;
    f32x4 s0, s1;
#pragma unroll
    for (int j = 0; j < 4; ++j) { s0[j] = gelu_tanh(v0[j]); s1[j] = gelu_tanh(v1[j]); }
    *(u32x4*)(zs5 + tok * DS5 + g * 16 + cc) = pack8(s0, s1);
  }
};
struct EpiGlu {
  typedef F8 Col; typedef u32x4 Aux;
  static constexpr bool PAIRED = false;
  __device__ __forceinline__ bool keep_acc(const Unit&) const { return false; }
  const bf16_t* zs5; const float* bias; bf16_t* zg;
  __device__ __forceinline__ Col col_prep(const Unit&, int col) const { F8 r; r.a = *(const f32x4*)(bias + col); r.b = *(const f32x4*)(bias + col + 4); return r; }
  __device__ __forceinline__ Aux load(const Unit&, int row, int col) const { return *(const u32x4*)(zs5 + (size_t)row * DS5 + col); }
  __device__ __forceinline__ void store(const Unit& un, int row, int col, f32x4& v0, f32x4& v1, const Col& bb, const Aux& zw) const {
    const F8 z = unpack8(zw); f32x4 s0, s1;
#pragma unroll
    for (int j = 0; j < 4; ++j) { s0[j] = z.a[j] * sigmoidf_(v0[j] + bb.a[j]); s1[j] = z.b[j] * sigmoidf_(v1[j] + bb.b[j]); }
    *(u32x4*)(zg + (size_t)row * DS5 + col) = pack8(s0, s1);
  }
};
struct EpiMerge {
  struct Aux { u32x4 g0, g1; }; typedef NoAux Col;
  const bf16_t* gate; bf16_t* merged;
  static constexpr bool PAIRED = false;
  __device__ __forceinline__ bool keep_acc(const Unit& un) const { return un.aux == 0; }
  __device__ __forceinline__ Col col_prep(const Unit&, int) const { return Col{}; }
  __device__ __forceinline__ Aux load(const Unit& un, int row, int col) const {
    Aux a; a.g1 = *(const u32x4*)(gate + (size_t)row * (2 * DM) + DM + col);
    a.g0 = (u32x4){0u, 0u, 0u, 0u};
    if (un.aux == 0) a.g0 = *(const u32x4*)(gate + (size_t)row * (2 * DM) + col);
    return a;
  }
  __device__ __forceinline__ void store(const Unit& un, int row, int col, f32x4& v0, f32x4& v1, const Col&, const Aux& a) const {
    const F8 g1 = unpack8(a.g1);
    if (un.aux == 0) {
      const F8 g0 = unpack8(a.g0);
#pragma unroll
      for (int j = 0; j < 4; ++j) { v0[j] = v0[j] * (g0.a[j] * __builtin_amdgcn_rcpf(fmaxf(g1.a[j], 1e-20f))); v1[j] = v1[j] * (g0.b[j] * __builtin_amdgcn_rcpf(fmaxf(g1.b[j], 1e-20f))); }
    } else {
      *(u32x4*)(merged + (size_t)row * DM + col) = pack8(g1.a * v0, g1.b * v1);
    }
  }
};
template <bool BASE_BF16>
struct EpiResid {
  typedef F8 Col; typedef F8 Aux;
  static constexpr bool PAIRED = false;
  __device__ __forceinline__ bool keep_acc(const Unit&) const { return false; }
  const void* base; const float* gmod; bf16_t* out;
  __device__ __forceinline__ Col col_prep(const Unit& un, int col) const { const float* p = gmod + (size_t)(un.r0 >> 11) * 6 * DM + col; F8 r; r.a = *(const f32x4*)p; r.b = *(const f32x4*)(p + 4); return r; }
  __device__ __forceinline__ Aux load(const Unit&, int row, int col) const {
    if (BASE_BF16) return unpack8(*(const u32x4*)((const bf16_t*)base + (size_t)row * DM + col));
    const float* p = (const float*)base + (size_t)row * DM + col; F8 r; r.a = __builtin_nontemporal_load((const f32x4*)p); r.b = __builtin_nontemporal_load((const f32x4*)(p + 4)); return r;
  }
  __device__ __forceinline__ void store(const Unit& un, int row, int col, f32x4& v0, f32x4& v1, const Col& g, const Aux& x) const {
    *(u32x4*)(out + (size_t)row * DM + col) = pack8(x.a + g.a * v0, x.b + g.b * v1);
  }
};
struct EpiGU {
  typedef NoAux Col; typedef NoAux Aux;
  static constexpr bool PAIRED = true;
  __device__ __forceinline__ bool keep_acc(const Unit&) const { return false; }
  bf16_t* act;
  __device__ __forceinline__ Col col_prep(const Unit&, int) const { return Col{}; }
  __device__ __forceinline__ Aux load(const Unit&, int, int) const { return Aux{}; }
  __device__ __forceinline__ void store(const Unit&, int, int, f32x4&, f32x4&, const Col&, const Aux&) const {}
  __device__ __forceinline__ void store_pair(const Unit& un, int row, int col, f32x4& g0, f32x4& g1, f32x4& u0, f32x4& u1) const {
    f32x4 a0, a1;
#pragma unroll
    for (int j = 0; j < 4; ++j) { a0[j] = siluf_(g0[j]) * u0[j]; a1[j] = siluf_(g1[j]) * u1[j]; }
    __builtin_nontemporal_store(pack8(a0, a1), (u32x4*)(act + (size_t)row * DFF + (col >> 8) * 128 + (col & 127)));
  }
};

typedef float f32x2 __attribute__((ext_vector_type(2)));
__device__ __forceinline__ void transpose_item(const float* __restrict__ W, int K, int N, bf16_t* __restrict__ WT, int item, int mode, float* scr, int lane) {
  const int nbn = N / 32, kb = item / nbn, nb = item % nbn, k0 = 64 * kb, n0 = 32 * nb;
#pragma unroll
  for (int i = 0; i < 32; ++i) { const int kk = 2 * i + (lane >> 5); scr[kk * 33 + (lane & 31)] = __builtin_nontemporal_load(&W[(size_t)(k0 + kk) * N + n0 + (lane & 31)]); }
  asm volatile("s_waitcnt lgkmcnt(0)" ::: "memory");
  const int c = lane & 7;
#pragma unroll
  for (int j = 0; j < 4; ++j) { const int n = (lane >> 3) + 8 * j; const float* t = scr + (8 * c) * 33 + n;
    u32x4 o; o.x = cvt_pk_bf16(t[0], t[33]); o.y = cvt_pk_bf16(t[2 * 33], t[3 * 33]); o.z = cvt_pk_bf16(t[4 * 33], t[5 * 33]); o.w = cvt_pk_bf16(t[6 * 33], t[7 * 33]);
    int dn = n0 + n; if (mode == 1) { const int a = (dn < DFF) ? dn : dn - DFF; dn = (a >> 7) * 256 + (a & 127) + ((dn < DFF) ? 0 : 128); }
    *(u32x4*)(WT + (size_t)dn * K + k0 + 8 * c) = o; }
  asm volatile("s_waitcnt lgkmcnt(0)" ::: "memory");
}

__device__ __forceinline__ void phase0(const Params& P, int bid, int G) {
  unsigned char* ws = P.ws; int tid = threadIdx.x; asm volatile("" : "+v"(tid)); const int lane = tid & 63, wave = __builtin_amdgcn_readfirstlane(tid >> 6);
  if (bid < 192) {
    float* cs = (float*)g_lds;
    float* red = (float*)(g_lds + 65536);
    for (int i = tid; i < NB * DM; i += NT) { const int b = i >> 10, k = i & 1023; cs[k * 16 + b] = siluf_(P.in[1][i]); }
    __syncthreads();
    for (int item = bid; item < 192; item += G) {
      const int col0 = item * 32, col = tid & 31, ks = tid >> 5;
      float acc[16];
#pragma unroll
      for (int b = 0; b < 16; ++b) acc[b] = 0.f;
      const float* wp = P.in[2] + (size_t)(ks * 64) * (6 * DM) + col0 + col;
      for (int k0 = 0; k0 < 64; k0 += 16) {
        float w[16];
#pragma unroll
        for (int u = 0; u < 16; ++u) w[u] = __builtin_nontemporal_load(&wp[(size_t)(k0 + u) * (6 * DM)]);
#pragma unroll
        for (int u = 0; u < 16; ++u) {
          const f32x4* c4 = (const f32x4*)(cs + (ks * 64 + k0 + u) * 16);
#pragma unroll
          for (int q = 0; q < 4; ++q) { const f32x4 cv = c4[q]; acc[4 * q] += cv[0] * w[u]; acc[4 * q + 1] += cv[1] * w[u]; acc[4 * q + 2] += cv[2] * w[u]; acc[4 * q + 3] += cv[3] * w[u]; }
        }
      }
#pragma unroll
      for (int b = 0; b < 16; ++b) red[(ks * 16 + b) * 32 + col] = acc[b];
      __syncthreads();
      { const int b = tid >> 5, c = tid & 31; float sum = P.in[3][col0 + c];
#pragma unroll
        for (int q = 0; q < 16; ++q) sum += red[(q * 16 + b) * 32 + c];
        ((float*)(ws + OFF_MOD))[b * 6 * DM + col0 + c] = sum; }
      __syncthreads();
    }
  }
  {
    const int vb = (bid + G - 192 % G) % G;
    for (int dg = vb; dg < 2 * S5G; dg += G) {
      const int d = dg >> 5, g = dg & 31;
      f32x2* pw = (f32x2*)g_lds;
      f32x4* cf = (f32x4*)(g_lds + 33 * 64 * 8);
      __syncthreads();
      if (tid < 64) { const S5Disc ds = s5_disc(P, d, g, tid); cf[tid] = (f32x4){ds.rho, ds.th, ds.cfr, ds.cfi};
        ((f32x2*)(ws + OFF_CF))[dg * 64 + tid] = (f32x2){ds.cfr, ds.cfi}; }
      __syncthreads();
      for (int i = tid; i < 33 * 64; i += NT) { const int k = i >> 6, p = i & 63; const f32x4 c4 = cf[p];
        S5Disc ds; ds.rho = c4[0]; ds.th = c4[1]; ds.cfr = c4[2]; ds.cfi = c4[3];
        float pr, pi; s5_pow(ds, k, pr, pi); pw[i] = (f32x2){pr, pi}; ((f32x2*)(ws + OFF_PW))[(size_t)dg * 33 * 64 + i] = (f32x2){pr, pi}; }
      __syncthreads();
      {
        float* csr = (float*)(g_lds + 17920); float* csi = csr + 16 * 65;
        float* bsr = csi + 16 * 65; float* bsi = bsr + 64 * 16;
#pragma unroll
        for (int r = 0; r < 2; ++r) { const int i = tid + NT * r;
          csr[(i >> 6) * 65 + (i & 63)] = P.in[12][(size_t)dg * 1024 + i]; csi[(i >> 6) * 65 + (i & 63)] = P.in[13][(size_t)dg * 1024 + i];
          bsr[i] = P.in[10][(size_t)dg * 1024 + i]; bsi[i] = P.in[11][(size_t)dg * 1024 + i]; }
        __syncthreads();
        const int c = tid & 15, k = tid >> 4;
        float acc[16];
#pragma unroll
        for (int j = 0; j < 16; ++j) acc[j] = 0.f;
#pragma unroll 4
        for (int p = 0; p < S5P; ++p) {
          const f32x2 pp = pw[k * 64 + p]; const f32x4 c4 = cf[p];
          const float cr = csr[c * 65 + p], ci = csi[c * 65 + p];
          const float wr_ = cr * pp[0] - ci * pp[1], wi_ = cr * pp[1] + ci * pp[0];
          const float w2r = wr_ * c4[2] - wi_ * c4[3], w2i = wr_ * c4[3] + wi_ * c4[2];
          const f32x4* br = (const f32x4*)(bsr + p * 16);
          const f32x4* bi = (const f32x4*)(bsi + p * 16);
#pragma unroll
          for (int q = 0; q < 4; ++q) { const f32x4 a = br[q], b = bi[q];
#pragma unroll
            for (int j = 0; j < 4; ++j) acc[4 * q + j] += w2r * a[j] - w2i * b[j]; }
        }
        float* kt = (float*)(ws + OFF_KTAB) + ((size_t)(dg * CT + k) * 16 + c) * 16;
#pragma unroll
        for (int q = 0; q < 4; ++q) *(f32x4*)(kt + 4 * q) = (f32x4){acc[4 * q], acc[4 * q + 1], acc[4 * q + 2], acc[4 * q + 3]};
      }
    }
  }
  __syncthreads();
  for (int t = bid * 8 + wave; t < SEQ; t += G * 8) {
    const int j = lane;
    const float t01 = (float)t / 2047.f;
    const int bi_ = lane & 15;
    const double band = 1e-4 + (double)bi_ * ((15.0 - 1e-4) / 15.0);
    float sv, cv; sincos_red(6.283185307179586476925 * (double)t * band / 2048.0, sv, cv);
    const float* w1 = P.in[19]; const float* w2 = P.in[21];
    float pre = P.in[20][j] + t01 * w1[j];
#pragma unroll
    for (int i = 0; i < 16; ++i) { pre += __shfl(cv, i) * w1[(1 + i) * 64 + j] + __shfl(sv, i) * w1[(17 + i) * 64 + j]; }
    const float fr_ = P.in[25][j];
    const float h1 = sinf(fr_ * pre);
    float pre2 = P.in[22][j];
#pragma unroll 16
    for (int i = 0; i < 64; ++i) pre2 += __shfl(h1, i) * w2[i * 64 + j];
    ((float*)(ws + OFF_H2TAB))[t * 64 + j] = sinf(fr_ * pre2);
  }
}

template <bool IN_BF16>
__device__ __forceinline__ void norm_mod_rows(const void* __restrict__ xin, const float* __restrict__ g, const float* __restrict__ mod, int sh_off, int sc_off,
                                              bf16_t* __restrict__ out, int bid, int G) {
  const int lane = threadIdx.x & 63, wave = threadIdx.x >> 6;
  for (int row0 = (bid * 8 + wave) * 2; row0 < NTOK; row0 += G * 16) {
    const int b = row0 >> 11;
    f32x4 v[2][4]; float s[2] = {0.f, 0.f};
#pragma unroll
    for (int r = 0; r < 2; ++r)
#pragma unroll
      for (int j = 0; j < 4; ++j) {
        if (IN_BF16) { const u32x2 w = ((const u32x2*)((const bf16_t*)xin + (size_t)(row0 + r) * DM))[lane + 64 * j]; v[r][j] = (f32x4){bflo(w.x), bfhi(w.x), bflo(w.y), bfhi(w.y)}; }
        else v[r][j] = ((const f32x4*)((const float*)xin + (size_t)(row0 + r) * DM))[lane + 64 * j];
        s[r] += (v[r][j][0] * v[r][j][0] + v[r][j][1] * v[r][j][1]) + (v[r][j][2] * v[r][j][2] + v[r][j][3] * v[r][j][3]); }
#pragma unroll
    for (int r = 0; r < 2; ++r) {
      const float rstd = 1.f / sqrtf(wave_sum(s[r]) * (1.f / DM) + 1e-6f);
      u32x2* o = (u32x2*)(out + (size_t)(row0 + r) * DM) + lane;
#pragma unroll
      for (int j = 0; j < 4; ++j) {
        const f32x4 gg = ((const f32x4*)g)[lane + 64 * j];
        const f32x4 sh = ((const f32x4*)(mod + (size_t)b * 6 * DM + sh_off))[lane + 64 * j];
        const f32x4 sc = ((const f32x4*)(mod + (size_t)b * 6 * DM + sc_off))[lane + 64 * j];
        f32x4 q;
#pragma unroll
        for (int e = 0; e < 4; ++e) q[e] = (v[r][j][e] * rstd * gg[e]) * (1.f + sc[e]) + sh[e];
        u32x2 w; w.x = cvt_pk_bf16(q[0], q[1]); w.y = cvt_pk_bf16(q[2], q[3]);
        o[64 * j] = w;
      }
    }
  }
}

__device__ __forceinline__ void phase1(const Params& P, int bid, int G) {
  unsigned char* ws = P.ws; int tid = threadIdx.x; asm volatile("" : "+v"(tid)); const int lane = tid & 63, wave = __builtin_amdgcn_readfirstlane(tid >> 6);
  const float* mod = (const float*)(ws + OFF_MOD);
  if (wave < 4) {
    const float* x = P.in[0]; const float* g = P.in[4]; bf16_t* out = (bf16_t*)(ws + OFF_H1);
    for (int row0 = (bid * 4 + wave) * 2; row0 < NTOK; row0 += G * 8) {
      f32x4 v[2][4]; float s[2] = {0.f, 0.f};
#pragma unroll
      for (int r = 0; r < 2; ++r)
#pragma unroll
        for (int j = 0; j < 4; ++j) { v[r][j] = __builtin_nontemporal_load(&((const f32x4*)(x + (size_t)(row0 + r) * DM))[lane + 64 * j]);
          s[r] += (v[r][j][0] * v[r][j][0] + v[r][j][1] * v[r][j][1]) + (v[r][j][2] * v[r][j][2] + v[r][j][3] * v[r][j][3]); }
      const int b = row0 >> 11;
#pragma unroll
      for (int r = 0; r < 2; ++r) {
        const float rstd = 1.f / sqrtf(wave_sum(s[r]) * (1.f / DM) + 1e-6f);
        u32x2* o = (u32x2*)(out + (size_t)(row0 + r) * DM) + lane;
#pragma unroll
        for (int j = 0; j < 4; ++j) {
          const f32x4 gg = ((const f32x4*)g)[lane + 64 * j];
          const f32x4 sh = ((const f32x4*)(mod + (size_t)b * 6 * DM))[lane + 64 * j];
          const f32x4 sc = ((const f32x4*)(mod + (size_t)b * 6 * DM + DM))[lane + 64 * j];
          f32x4 q;
#pragma unroll
          for (int e = 0; e < 4; ++e) q[e] = (v[r][j][e] * rstd * gg[e]) * (1.f + sc[e]) + sh[e];
          u32x2 w; w.x = cvt_pk_bf16(q[0], q[1]); w.y = cvt_pk_bf16(q[2], q[3]);
          o[64 * j] = w;
        }
      }
    }
    return;
  }
  const int tw = bid * 4 + (wave - 4), NTWAVES = G * 4;
  { float* scr = (float*)(g_lds + 16384 + (wave - 4) * 9216);
    for (int it = tw; it < (DM / 64) * (DIN / 32); it += NTWAVES) transpose_item(P.in[6], DM, DIN, (bf16_t*)(ws + OFF_WIN), it, 0, scr, lane); }
  {
    const float* h2tab = (const float*)(ws + OFF_H2TAB);
    bf16_t* hf = (bf16_t*)(ws + OFF_HF);
    const float* w3 = P.in[23];
    float* wsl = (float*)(g_lds + (wave - 4) * 4096);
    for (int item = tw; item < 1024; item += NTWAVES) {
      const int tb = item & 31, cb4 = item >> 5, t = tb * 64 + lane;
      f32x4 h[16];
#pragma unroll
      for (int q = 0; q < 16; ++q) h[q] = *(const f32x4*)(h2tab + t * 64 + 4 * q);
      const float t01 = (float)t / 2047.f;
      for (int sl = 0; sl < 4; ++sl) {
        const int cb = cb4 * 4 + sl;
        asm volatile("s_waitcnt lgkmcnt(0)" ::: "memory");
#pragma unroll
        for (int k = 0; k < 16; ++k) { const int i = lane + 64 * k, ii = i >> 4, cc = i & 15; wsl[cc * 64 + ii] = w3[ii * 2048 + cb * 16 + cc]; }
        asm volatile("s_waitcnt lgkmcnt(0)" ::: "memory");
        for (int cc = 0; cc < 16; ++cc) {
          const int col = cb * 16 + cc;
          float a = P.in[24][col];
          const f32x4* wv = (const f32x4*)(wsl + cc * 64);
#pragma unroll
          for (int q = 0; q < 16; ++q) { const f32x4 w4 = wv[q]; a += h[q][0] * w4[0] + h[q][1] * w4[1] + h[q][2] * w4[2] + h[q][3] * w4[3]; }
          const float val = a * expf(-t01 * fabsf(P.in[26][col]));
          const int o = col >> 10, dir = (col >> 9) & 1, c = col & 511;
          bf16_t* dst = hf + (size_t)(o * DHY + c) * 4096;
          if (dir == 0) dst[2048 - t] = f2bf(val);
          else { if (t == 0) dst[0] = 0; else dst[2048 + t] = f2bf(val); }
        }
      }
    }
  }
  const int wt = tw * 64 + lane, NWT = NTWAVES * 64;
  const float* ktab = (const float*)(ws + OFF_KTAB);
  bf16_t* mcat = (bf16_t*)(ws + OFF_MCAT);
  for (int idx0 = wt; idx0 < S5G * 512 * (UEXT_LD / 4); idx0 += 4 * NWT) {
    u32x2 wv[4];
#pragma unroll
    for (int u = 0; u < 4; ++u) {
      const int idx = idx0 + u * NWT;
      const int kq = idx % (UEXT_LD / 4), rc = idx / (UEXT_LD / 4), row = rc & 511, g = rc >> 9, t = row >> 4, c = row & 15;
      const int kk = kq * 4;
      float v[4];
      if (kk < 512) {
        const int s = kk >> 4, c0 = kk & 15;
        f32x4 a4 = (f32x4){0.f, 0.f, 0.f, 0.f};
        if (t >= s) a4 += *(const f32x4*)(ktab + (((0 * S5G + g) * CT + (t - s)) * 16 + c) * 16 + c0);
        if (s >= t) a4 += *(const f32x4*)(ktab + (((1 * S5G + g) * CT + (s - t)) * 16 + c) * 16 + c0);
        const float dd = (s == t) ? P.in[14][g * 16 + c] : 0.f;
#pragma unroll
        for (int j = 0; j < 4; ++j) v[j] = a4[j] + ((c == c0 + j) ? dd : 0.f);
      } else {
        const int q = kk - 512, d = q >> 7, comp = (q >> 6) & 1, p0 = q & 63, dg = d * S5G + g;
        const f32x2* pwp = (const f32x2*)(ws + OFF_PW) + ((size_t)dg * 33 + (d == 0 ? (t + 1) : (CT - t))) * 64 + p0;
        const f32x4 cr4 = *(const f32x4*)(P.in[12] + ((size_t)dg * S5C + c) * S5P + p0), ci4 = *(const f32x4*)(P.in[13] + ((size_t)dg * S5C + c) * S5P + p0);
#pragma unroll
        for (int j = 0; j < 4; ++j) { const f32x2 pp = pwp[j]; v[j] = comp == 0 ? (cr4[j] * pp[0] - ci4[j] * pp[1]) : -(cr4[j] * pp[1] + ci4[j] * pp[0]); }
      }
      wv[u].x = cvt_pk_bf16(v[0], v[1]); wv[u].y = cvt_pk_bf16(v[2], v[3]);
    }
#pragma unroll
    for (int u = 0; u < 4; ++u) {
      const int idx = idx0 + u * NWT;
      const int kq = idx % (UEXT_LD / 4), rc = idx / (UEXT_LD / 4);
      *(u32x2*)(mcat + (size_t)rc * UEXT_LD + kq * 4) = wv[u];
    }
  }
  bf16_t* pcat = (bf16_t*)(ws + OFF_PCAT);
  for (int idx0 = wt; idx0 < S5G * 256 * 128; idx0 += 4 * NWT) {
    u32x2 wv[4];
#pragma unroll
    for (int u = 0; u < 4; ++u) {
      const int idx = idx0 + u * NWT;
      const int kq = idx & 127, row = (idx >> 7) & 255, g = idx >> 15;
      const int d = row >> 7, comp = (row >> 6) & 1, p = row & 63, kk = kq * 4, s = kk >> 4, c0 = kk & 15;
      const int dg = d * S5G + g;
      const f32x2 pp = ((const f32x2*)(ws + OFF_PW))[((size_t)dg * 33 + (d == 0 ? (CT - 1 - s) : s)) * 64 + p];
      const f32x2 cfv = ((const f32x2*)(ws + OFF_CF))[dg * 64 + p];
      const float wr_ = pp[0] * cfv[0] - pp[1] * cfv[1], wi_ = pp[0] * cfv[1] + pp[1] * cfv[0];
      const f32x4 br = *(const f32x4*)(P.in[10] + ((size_t)dg * S5P + p) * S5C + c0);
      const f32x4 bi = *(const f32x4*)(P.in[11] + ((size_t)dg * S5P + p) * S5C + c0);
      float v[4];
#pragma unroll
      for (int j = 0; j < 4; ++j) v[j] = comp == 0 ? (wr_ * br[j] - wi_ * bi[j]) : (wr_ * bi[j] + wi_ * br[j]);
      wv[u].x = cvt_pk_bf16(v[0], v[1]); wv[u].y = cvt_pk_bf16(v[2], v[3]);
    }
#pragma unroll
    for (int u = 0; u < 4; ++u) { const int idx = idx0 + u * NWT; *(u32x2*)(pcat + (size_t)idx * 4) = wv[u]; }
  }
}

__device__ __forceinline__ void s5_carry(const Params& P, int bid, int G) {
  unsigned char* ws = P.ws;
  const float* E = (const float*)(ws + OFF_E);
  bf16_t* uext = (bf16_t*)(ws + OFF_UEXT);
  for (int idx = bid * 256 + (threadIdx.x & 255) + (threadIdx.x >> 8) * 256 * G; idx < S5G * NB * 2 * S5P; idx += 2 * 256 * G) {
    const int p = idx & 63, d = (idx >> 6) & 1, b = (idx >> 7) & 15, g = idx >> 11;
    const f32x2 aT = ((const f32x2*)(ws + OFF_PW))[((size_t)(d * S5G + g) * 33 + CT) * 64 + p];
    const float ar = aT[0], ai = aT[1];
    const size_t rbase = (size_t)g * 1024 + b * NCH;
    const float* ep = E + rbase * 256 + d * 128 + p; asm volatile("" : "+v"(ep));
    bf16_t* up = uext + rbase * UEXT_LD + 512 + d * 128 + p; asm volatile("" : "+v"(up));
    float er[NCH], ei[NCH];
#pragma unroll
    for (int j = 0; j < NCH; ++j) { er[j] = ep[j * 256]; ei[j] = ep[j * 256 + 64]; }
    float sr = 0.f, si = 0.f;
    if (d == 0) {
#pragma unroll
      for (int j = 0; j < NCH; ++j) {
        up[j * UEXT_LD] = f2bf(sr); up[j * UEXT_LD + 64] = f2bf(si);
        const float nr = ar * sr - ai * si + er[j], ni = ar * si + ai * sr + ei[j]; sr = nr; si = ni; }
    } else {
#pragma unroll
      for (int j = NCH - 1; j >= 0; --j) {
        up[j * UEXT_LD] = f2bf(sr); up[j * UEXT_LD + 64] = f2bf(si);
        const float nr = ar * sr - ai * si + er[j], ni = ar * si + ai * sr + ei[j]; sr = nr; si = ni; }
    }
  }
}

constexpr int HY_RSTRIDE = 8224;
constexpr int HY_ZOFF = 8 * HY_RSTRIDE;
constexpr int HY_ZSTRIDE = 4112;
static_assert(HY_ZOFF + 16 * HY_ZSTRIDE <= LDS_BYTES, "hyena lds");

__device__ __forceinline__ f32x4 hy_conv4(const bf16_t* __restrict__ uhyt, const float* __restrict__ cw, const float* __restrict__ cb, int chn, int b, int t) {
  const bf16_t* u = uhyt + ((size_t)chn * NB + b) * SEQ + t;
  const u32x2 m = *(const u32x2*)u;
  const float um = (t > 0) ? bf2f(u[-1]) : 0.f, up = (t + 4 < SEQ) ? bf2f(u[4]) : 0.f;
  const float u0 = bflo(m.x), u1 = bfhi(m.x), u2 = bflo(m.y), u3 = bfhi(m.y);
  const float w0 = cw[chn], w1 = cw[3 * DHY + chn], w2 = cw[6 * DHY + chn], bb = cb[chn];
  return (f32x4){bb + w0 * um + w1 * u0 + w2 * u1, bb + w0 * u0 + w1 * u1 + w2 * u2, bb + w0 * u1 + w1 * u2 + w2 * u3, bb + w0 * u2 + w1 * u3 + w2 * up};
}

__device__ __forceinline__ void hy_toeplitz(f32x4 (&acc)[16], int wave, int lane) {
  LAS const unsigned char* lds = (LAS const unsigned char*)g_lds;
  const int m = lane & 15, kq = lane >> 4;
  const int cm = (m + 7) >> 3, r = (8 * cm - m);
  LAS const unsigned char* abase = lds + r * HY_RSTRIDE + (kq - cm) * 16 + (2048 - 256 * wave) * 2;
  LAS const unsigned char* bbase = lds + HY_ZOFF + m * HY_ZSTRIDE + kq * 16;
#pragma unroll
  for (int tb = 0; tb < 16; ++tb) acc[tb] = (f32x4){0.f, 0.f, 0.f, 0.f};
  bf16x8 F[16];
#pragma unroll
  for (int f = 0; f < 16; ++f) F[f] = *(LAS const bf16x8*)(abase - 32 * f);
  bf16x8 bcur = *(LAS const bf16x8*)(bbase);
  for (int it = 0; it < 8; ++it) {
    LAS const unsigned char* ab = abase + 512 * it;
    LAS const unsigned char* bb = bbase + 512 * it;
#pragma unroll
    for (int u = 0; u < 8; ++u) {
      acc[14] = __builtin_amdgcn_mfma_f32_16x16x32_bf16(F[(14 - 2 * u) & 15], bcur, acc[14], 0, 0, 0);
      acc[15] = __builtin_amdgcn_mfma_f32_16x16x32_bf16(F[(15 - 2 * u) & 15], bcur, acc[15], 0, 0, 0);
      F[(14 - 2 * u) & 15] = *(LAS const bf16x8*)(ab + 64 * (u + 1));
      F[(15 - 2 * u) & 15] = *(LAS const bf16x8*)(ab + 64 * (u + 1) - 32);
      const bf16x8 bnext = *(LAS const bf16x8*)(bb + 64 * (u + 1));
#pragma unroll
      for (int tb = 0; tb < 14; ++tb)
        acc[tb] = __builtin_amdgcn_mfma_f32_16x16x32_bf16(F[(tb - 2 * u) & 15], bcur, acc[tb], 0, 0, 0);
      bcur = bnext;
      __builtin_amdgcn_sched_barrier(0);
    }
  }
}

struct HyRaw { u32x2 m; unsigned short um, up; };
__device__ __forceinline__ HyRaw hy_raw(const bf16_t* __restrict__ up_, int t) {
  HyRaw r; r.m = *(const u32x2*)up_;
  r.um = up_[t > 0 ? -1 : 0]; r.up = up_[t + 4 < SEQ ? 4 : 3];
  if (t == 0) r.um = 0; if (t + 4 >= SEQ) r.up = 0;
  return r;
}
__device__ __forceinline__ f32x4 hy_conv_raw(const HyRaw& r, float w0, float w1, float w2, float bb) {
  const float um = bf2f(r.um), up = bf2f(r.up), u0 = bflo(r.m.x), u1 = bfhi(r.m.x), u2 = bflo(r.m.y), u3 = bfhi(r.m.y);
  return (f32x4){bb + w0 * um + w1 * u0 + w2 * u1, bb + w0 * u0 + w1 * u1 + w2 * u2, bb + w0 * u1 + w1 * u2 + w2 * u3, bb + w0 * u2 + w1 * u3 + w2 * up};
}
__device__ __forceinline__ void hy_build_filter(const u32x4& raw) {
  const int tid = threadIdx.x;
  *(u32x4*)(g_lds + tid * 16) = raw;
  __syncthreads();
  u32x4 nx = (u32x4){0u, 0u, 0u, 0u};
  if (tid < 511) nx = *(const u32x4*)(g_lds + (tid + 1) * 16);
  const unsigned d[8] = {raw.x, raw.y, raw.z, raw.w, nx.x, nx.y, nx.z, nx.w};
#pragma unroll
  for (int r = 1; r < 8; ++r) {
    u32x4 o;
    if ((r & 1) == 0) { o.x = d[r / 2]; o.y = d[r / 2 + 1]; o.z = d[r / 2 + 2]; o.w = d[r / 2 + 3]; }
    else { const int a = (r - 1) / 2;
      o.x = __builtin_amdgcn_alignbit(d[a + 1], d[a], 16); o.y = __builtin_amdgcn_alignbit(d[a + 2], d[a + 1], 16);
      o.z = __builtin_amdgcn_alignbit(d[a + 3], d[a + 2], 16); o.w = __builtin_amdgcn_alignbit(d[a + 4], d[a + 3], 16); }
    *(u32x4*)(g_lds + r * HY_RSTRIDE + tid * 16) = o;
  }
}

__device__ __forceinline__ void hy_gate_raw(HyRaw (&raw)[16], const bf16_t* xp, int tl, int lane, int fq) {
  u32x2 mm[16];
#pragma unroll
  for (int tb = 0; tb < 16; ++tb) mm[tb] = *(const u32x2*)(xp + 16 * tb);
  unsigned short um0 = xp[tl > 0 ? -1 : 0]; if (tl == 0) um0 = 0;
  const int t15 = tl + 240;
  unsigned short up15 = (xp + 240)[t15 + 4 < SEQ ? 4 : 3]; if (t15 + 4 >= SEQ) up15 = 0;
#pragma unroll
  for (int tb = 0; tb < 16; ++tb) {
    const unsigned sl = (fq == 3 && tb > 0) ? mm[tb > 0 ? tb - 1 : 0].y : mm[tb].y;
    const unsigned lw = (unsigned)__shfl((int)sl, (lane + 48) & 63);
    unsigned short um = (unsigned short)(lw >> 16);
    if (tb == 0) um = (fq == 0) ? um0 : um;
    const unsigned sr = (fq == 0 && tb < 15) ? mm[tb < 15 ? tb + 1 : 15].x : mm[tb].x;
    const unsigned rw = (unsigned)__shfl((int)sr, (lane + 16) & 63);
    unsigned short up = (unsigned short)(rw & 0xffffu);
    if (tb == 15) up = (fq == 3) ? up15 : up;
    raw[tb].m = mm[tb]; raw[tb].um = um; raw[tb].up = up;
  }
}

__device__ __forceinline__ void hyena_phase(const Params& P, int bid, int G) {
  unsigned char* ws = P.ws; int tid = threadIdx.x; asm volatile("" : "+v"(tid)); const int lane = tid & 63, wave = __builtin_amdgcn_readfirstlane(tid >> 6);
  LAS unsigned char* lds = (LAS unsigned char*)g_lds;
  const bf16_t* uhyt = (const bf16_t*)(ws + OFF_UHYT);
  const bf16_t* hf = (const bf16_t*)(ws + OFF_HF);
  bf16_t* zhyT = (bf16_t*)(ws + OFF_ZS5);
  const float* cw = P.in[17]; const float* cb = P.in[18];
  const int fr = lane & 15, fq = lane >> 4;
  for (int c = bid; c < DHY; c += G) {
    const u32x4 f0raw = *(const u32x4*)(hf + (size_t)(0 * DHY + c) * 4096 + tid * 8);
    const u32x4 f1raw = *(const u32x4*)(hf + (size_t)(1 * DHY + c) * 4096 + tid * 8);
    __syncthreads();
#pragma unroll 1
    for (int half = 0; half < 2; ++half) {
      f32x4 v[8];
#pragma unroll
      for (int i = 0; i < 8; ++i) { const int task = tid + (half * 8 + i) * NT, b = task >> 9, t = (task & 511) * 4; v[i] = hy_conv4(uhyt, cw, cb, c, b, t); }
#pragma unroll
      for (int i = 0; i < 8; ++i) { const int task = tid + (half * 8 + i) * NT, b = task >> 9, t = (task & 511) * 4;
        u32x2 w; w.x = cvt_pk_bf16(v[i][0], v[i][1]); w.y = cvt_pk_bf16(v[i][2], v[i][3]);
        *(LAS u32x2*)(lds + HY_ZOFF + b * HY_ZSTRIDE + t * 2) = w; }
    }
    hy_build_filter(f0raw);
    __syncthreads();
    f32x4 acc[16];
    hy_toeplitz(acc, wave, lane);
    const float bias0 = P.in[27][c], bias1 = P.in[27][DHY + c];
    u32x2 z1[16];
    {
      const int chn = DHY + c;
      const float w0 = cw[chn], w1 = cw[3 * DHY + chn], w2 = cw[6 * DHY + chn], bb = cb[chn];
      const int tl = 256 * wave + 4 * fq;
      const bf16_t* xp = uhyt + ((size_t)chn * NB + fr) * SEQ + tl; asm volatile("" : "+v"(xp));
      HyRaw raw[16];
      hy_gate_raw(raw, xp, tl, lane, fq);
#pragma unroll
      for (int tb = 0; tb < 16; ++tb) {
        const int t = tl + 16 * tb;
        const u32x2 zv = *(LAS const u32x2*)(lds + HY_ZOFF + fr * HY_ZSTRIDE + t * 2);
        const f32x4 x1 = hy_conv_raw(raw[tb], w0, w1, w2, bb);
        z1[tb].x = cvt_pk_bf16(x1[0] * (acc[tb][0] + bias0 * bflo(zv.x)), x1[1] * (acc[tb][1] + bias0 * bfhi(zv.x)));
        z1[tb].y = cvt_pk_bf16(x1[2] * (acc[tb][2] + bias0 * bflo(zv.y)), x1[3] * (acc[tb][3] + bias0 * bfhi(zv.y)));
      }
    }
    __syncthreads();
#pragma unroll
    for (int tb = 0; tb < 16; ++tb) {
      const int t = 256 * wave + 16 * tb + 4 * fq;
      *(LAS u32x2*)(lds + HY_ZOFF + fr * HY_ZSTRIDE + t * 2) = z1[tb];
    }
    hy_build_filter(f1raw);
    __syncthreads();
    hy_toeplitz(acc, wave, lane);
    {
      const int chn = 2 * DHY + c;
      const float w0 = cw[chn], w1 = cw[3 * DHY + chn], w2 = cw[6 * DHY + chn], bb = cb[chn];
      const int tl = 256 * wave + 4 * fq;
      const bf16_t* xp = uhyt + ((size_t)chn * NB + fr) * SEQ + tl; asm volatile("" : "+v"(xp));
      bf16_t* zp = zhyT + ((size_t)c * NB + fr) * SEQ + tl; asm volatile("" : "+v"(zp));
      HyRaw raw[16];
      hy_gate_raw(raw, xp, tl, lane, fq);
#pragma unroll
      for (int tb = 0; tb < 16; ++tb) {
        const int t = tl + 16 * tb;
        const u32x2 zv = *(LAS const u32x2*)(lds + HY_ZOFF + fr * HY_ZSTRIDE + t * 2);
        const f32x4 x2 = hy_conv_raw(raw[tb], w0, w1, w2, bb);
        u32x2 w;
        w.x = cvt_pk_bf16(x2[0] * (acc[tb][0] + bias1 * bflo(zv.x)), x2[1] * (acc[tb][1] + bias1 * bfhi(zv.x)));
        w.y = cvt_pk_bf16(x2[2] * (acc[tb][2] + bias1 * bflo(zv.y)), x2[3] * (acc[tb][3] + bias1 * bfhi(zv.y)));
        *(u32x2*)(zp + 16 * tb) = w;
      }
    }
  }
  __syncthreads();
}

__device__ __forceinline__ void zhy_transpose(unsigned char* ws, int bid, int G) {
  int tid = threadIdx.x; asm volatile("" : "+v"(tid)); const int lane = tid & 63, wave = __builtin_amdgcn_readfirstlane(tid >> 6);
  LAS unsigned char* tl = (LAS unsigned char*)g_lds + wave * 9216;
  const bf16_t* zhyT = (const bf16_t*)(ws + OFF_ZS5);
  bf16_t* zhy = (bf16_t*)(ws + OFF_ZHY);
  const int r8 = lane >> 3, q8 = lane & 7;
  for (int tile = bid * 8 + wave; tile < 4096; tile += G * 8) {
    const int cb = tile & 7, tb = tile >> 3;
    u32x4 v[8];
#pragma unroll
    for (int i = 0; i < 8; ++i) v[i] = *(const u32x4*)(zhyT + (size_t)(cb * 64 + 8 * i + r8) * NTOK + tb * 64 + q8 * 8);
#pragma unroll
    for (int i = 0; i < 8; ++i) {
      const int cl = 8 * i + r8;
#pragma unroll
      for (int j = 0; j < 8; ++j) {
        const unsigned wv = v[i][j >> 1];
        *(LAS unsigned short*)(tl + (q8 * 8 + j) * 144 + cl * 2) = (unsigned short)((j & 1) ? (wv >> 16) : (wv & 0xffffu));
      }
    }
    asm volatile("s_waitcnt lgkmcnt(0)" ::: "memory");
#pragma unroll
    for (int i = 0; i < 8; ++i) {
      const int tokl = 8 * i + r8;
      const u32x4 o = *(LAS const u32x4*)(tl + tokl * 144 + q8 * 16);
      *(u32x4*)(zhy + (size_t)(tb * 64 + tokl) * DHY + cb * 64 + q8 * 8) = o;
    }
    asm volatile("s_waitcnt lgkmcnt(0)" ::: "memory");
  }
}

__device__ __forceinline__ void late_transposes(const Params& P, int bid, int G) {
  unsigned char* ws = P.ws; int tid = threadIdx.x; asm volatile("" : "+v"(tid)); const int lane = tid & 63, wave = __builtin_amdgcn_readfirstlane(tid >> 6);
  constexpr int I_GLU = (DS5 / 64) * (DS5 / 32), I_A = (DS5 / 64) * (DM / 32), I_B = I_A,
                I_OUT = (DM / 64) * (DM / 32), I_GU = (DM / 64) * (2 * DFF / 32), I_DN = (DFF / 64) * (DM / 32);
  constexpr int NITEMS = I_GLU + I_A + I_B + I_OUT + I_GU + I_DN;
  float* scr = (float*)(g_lds + wave * 9216);
  const int slot = (wave >= 4) ? (bid * 4 + (wave - 4)) * 2 : -1, nslot = G * 12;
  for (int rep = 0; rep < 3; ++rep) {
    int first;
    if (wave >= 4) { if (rep == 2) break; first = (bid * 4 + (wave - 4)) * 2 + rep; } else { if (rep > 0) break; first = G * 8 + bid * 4 + wave; }
    for (int it = first; it < NITEMS; it += nslot) {
      int r = it;
      if (r < I_GLU) { transpose_item(P.in[15], DS5, DS5, (bf16_t*)(ws + OFF_WGLU), r, 0, scr, lane); continue; } r -= I_GLU;
      if (r < I_A) { transpose_item(P.in[28], DS5, DM, (bf16_t*)(ws + OFF_WA), r, 0, scr, lane); continue; } r -= I_A;
      if (r < I_B) { transpose_item(P.in[29], DHY, DM, (bf16_t*)(ws + OFF_WB), r, 0, scr, lane); continue; } r -= I_B;
      if (r < I_OUT) { transpose_item(P.in[30], DM, DM, (bf16_t*)(ws + OFF_WOUT), r, 0, scr, lane); continue; } r -= I_OUT;
      if (r < I_GU) { transpose_item(P.in[31], DM, 2 * DFF, (bf16_t*)(ws + OFF_WGU), r, 1, scr, lane); continue; } r -= I_GU;
      transpose_item(P.in[32], DFF, DM, (bf16_t*)(ws + OFF_WDOWN), r, 0, scr, lane);
    }
  }
  (void)slot;
}

#define XB_TMO      128
#define XB_XCNT(j)  (256  + 64 * (j))
#define XB_XSUB(j)  (1280 + 64 * (j))
#define XB_XGEN(j)  (2304 + 64 * (j))
#define XB_TOP      3328
#define XB_TOPGEN   3392
#define XCD_BAR_WORDS 3456
#define XB_SPIN_CAP (1u << 18)
__device__ __forceinline__ unsigned xb_ld(unsigned* p)              { return __hip_atomic_load(p, __ATOMIC_RELAXED, __HIP_MEMORY_SCOPE_AGENT); }
__device__ __forceinline__ unsigned xb_add(unsigned* p, unsigned v) { return __hip_atomic_fetch_add(p, v, __ATOMIC_RELAXED, __HIP_MEMORY_SCOPE_AGENT); }
__device__ __forceinline__ unsigned xb_xcc_id() { return (unsigned)__builtin_amdgcn_s_getreg((3 << 11) | 20) & 0xFu; }
#define XB_SPIN(cond, bar) do { unsigned _sp = 0; while (cond) { __builtin_amdgcn_s_sleep(1); \
    if ((++_sp & 255u) == 0u) { if (xb_ld(&(bar)[XB_TMO])) break; if (_sp > XB_SPIN_CAP) { atomicAdd(&(bar)[XB_TMO], 1u); break; } } } } while (0)
struct XcdBarrier { unsigned* bar; unsigned x; volatile LAS unsigned* st; };
__device__ __forceinline__ XcdBarrier xcd_barrier_post(unsigned* bar, volatile LAS unsigned* st) {
  XcdBarrier b; b.bar = bar; b.x = xb_xcc_id(); b.st = st;
  if (threadIdx.x == 0) (void)xb_add(&bar[XB_XCNT(b.x)], 1u);
  return b;
}
__device__ __forceinline__ void xcd_barrier_complete(unsigned* bar, unsigned x, unsigned& nloc, unsigned& nx) {
  const unsigned G = gridDim.x * gridDim.y * gridDim.z;
  unsigned sum, cnt, mine, sp = 0u;
  for (;;) {
    sum = 0u; cnt = 0u; mine = 0u;
#pragma unroll
    for (unsigned j = 0; j < 16; ++j) { const unsigned c = xb_ld(&bar[XB_XCNT(j)]); sum += c; cnt += (c > 0u) ? 1u : 0u; mine = (j == x) ? c : mine; }
    if (sum == G) break;
    __builtin_amdgcn_s_sleep(1);
    if ((++sp & 255u) == 0u) { if (xb_ld(&bar[XB_TMO])) break; if (sp > XB_SPIN_CAP) { atomicAdd(&bar[XB_TMO], 1u); break; } }
  }
  nloc = mine > 0u ? mine : 1u; nx = cnt > 0u ? cnt : 1u;
}
__device__ __forceinline__ void xcd_barrier(const XcdBarrier& b) {
  asm volatile("s_waitcnt vmcnt(0)" ::: "memory");
  __syncthreads();
  if (threadIdx.x == 0) {
    unsigned* bar = b.bar;
    __builtin_amdgcn_s_waitcnt(0);
    unsigned nloc = b.st[0], nx = b.st[1];
    if (nloc == 0u) { xcd_barrier_complete(bar, b.x, nloc, nx); b.st[0] = nloc; b.st[1] = nx; }
    const unsigned old = xb_add(&bar[XB_XSUB(b.x)], 1u);
    const unsigned gen = old / nloc;
    if (old + 1u == (gen + 1u) * nloc) {
      __builtin_amdgcn_fence(__ATOMIC_RELEASE, "agent");
      asm volatile("s_waitcnt vmcnt(0)" ::: "memory");
      const unsigned og = xb_add(&bar[XB_TOP], 1u);
      const unsigned tg = og / nx;
      if (og + 1u == (tg + 1u) * nx) xb_add(&bar[XB_TOPGEN], 1u);
      else XB_SPIN(xb_ld(&bar[XB_TOPGEN]) == tg, bar);
      __builtin_amdgcn_fence(__ATOMIC_ACQUIRE, "agent");
      xb_add(&bar[XB_XGEN(b.x)], 1u);
      asm volatile("s_waitcnt vmcnt(0)" ::: "memory");
    } else {
      XB_SPIN(xb_ld(&bar[XB_XGEN(b.x)]) == gen, bar);
      __builtin_amdgcn_fence(__ATOMIC_ACQUIRE, "agent");
      asm volatile("s_waitcnt vmcnt(0)" ::: "memory");
    }
  }
  __syncthreads();
}

__global__ void __launch_bounds__(NT) mega(Params P) {
  cg::grid_group grid = cg::this_grid();
  unsigned char* ws = P.ws;
  const int G = gridDim.x, bid = blockIdx.x;
  const float* mod = (const float*)(ws + OFF_MOD);

  volatile LAS unsigned* xst = (volatile LAS unsigned*)((LAS unsigned char*)g_lds + LDS_BYTES - 16);
  if (threadIdx.x == 0) { xst[0] = 0u; xst[1] = 0u; }
  __syncthreads();
  XcdBarrier xb = xcd_barrier_post((unsigned*)(ws + OFF_BAR), xst);
  phase0(P, bid, G);
  grid.sync();
  phase1(P, bid, G);
  xcd_barrier(xb);
  { EpiIn e{(bf16_t*)(ws + OFF_UEXT), (bf16_t*)(ws + OFF_UHYT), (bf16_t*)(ws + OFF_GATE)};
    SchedGrid sc{(const char*)(ws + OFF_H1), (const char*)(ws + OFF_WIN), DM, DM, NTOK / BM, DIN / BM, G, bid};
    gemm_phase(DM, DM, DM, sc, e); }
  xcd_barrier(xb);
  { EpiS5E e{(float*)(ws + OFF_E)};
    SchedGrouped sc{(const char*)(ws + OFF_UEXT), (const char*)(ws + OFF_PCAT), UEXT_LD, 512, 1, S5G * 4, G, bid};
    gemm_phase(UEXT_LD, 512, 512, sc, e); }
  hyena_phase(P, bid, G);
  xcd_barrier(xb);
  s5_carry(P, bid, G);
  zhy_transpose(ws, bid, G);
  late_transposes(P, bid, G);
  xcd_barrier(xb);
  { EpiS5Out e{(bf16_t*)(ws + OFF_ZS5)};
    SchedGrouped sc{(const char*)(ws + OFF_UEXT), (const char*)(ws + OFF_MCAT), UEXT_LD, UEXT_LD, 2, S5G * 8, G, bid};
    gemm_phase(UEXT_LD, UEXT_LD, UEXT_LD, sc, e); }
  xcd_barrier(xb);
  { EpiGlu e{(const bf16_t*)(ws + OFF_ZS5), P.in[16], (bf16_t*)(ws + OFF_ZG)};
    SchedGrid sc{(const char*)(ws + OFF_ZS5), (const char*)(ws + OFF_WGLU), DS5, DS5, NTOK / BM, DS5 / BM, G, bid};
    gemm_phase(DS5, DS5, DS5, sc, e); }
  xcd_barrier(xb);
  { EpiMerge e{(const bf16_t*)(ws + OFF_GATE), (bf16_t*)(ws + OFF_MERGED)};
    SchedPair sc{(const char*)(ws + OFF_ZG), (const char*)(ws + OFF_WA), (const char*)(ws + OFF_ZHY), (const char*)(ws + OFF_WB), DS5, DS5, NTOK / BM, DM / BM, G, bid};
    gemm_phase(DS5, DS5, DS5, sc, e); }
  xcd_barrier(xb);
  { EpiResid<false> e{P.in[0], mod + 2 * DM, (bf16_t*)(ws + OFF_X1B)};
    SchedGrid sc{(const char*)(ws + OFF_MERGED), (const char*)(ws + OFF_WOUT), DM, DM, NTOK / BM, DM / BM, G, bid};
    gemm_phase(DM, DM, DM, sc, e); }
  xcd_barrier(xb);
  norm_mod_rows<true>(ws + OFF_X1B, P.in[5], mod, 3 * DM, 4 * DM, (bf16_t*)(ws + OFF_H1), bid, G);
  xcd_barrier(xb);
  { EpiGU e{(bf16_t*)(ws + OFF_ACT)};
    SchedGrid sc{(const char*)(ws + OFF_H1), (const char*)(ws + OFF_WGU), DM, DM, NTOK / BM, 2 * DFF / BM, G, bid};
    gemm_phase(DM, DM, DM, sc, e); }
  xcd_barrier(xb);
  { EpiResid<true> e{ws + OFF_X1B, mod + 5 * DM, (bf16_t*)(ws + OFF_X2B)};
    SchedGrid sc{(const char*)(ws + OFF_ACT), (const char*)(ws + OFF_WDOWN), DFF, DFF, NTOK / BM, DM / BM, G, bid};
    gemm_phase(DFF, DFF, DFF, sc, e); }
  xcd_barrier(xb);
  { const int lane = threadIdx.x & 63, wave = threadIdx.x >> 6;
    for (int row0 = (bid * 8 + wave) * 2; row0 < NTOK; row0 += G * 16) {
      f32x4 v[2][4]; float s[2] = {0.f, 0.f};
#pragma unroll
      for (int r = 0; r < 2; ++r) {
        const u32x2* xr = (const u32x2*)((const bf16_t*)(ws + OFF_X2B) + (size_t)(row0 + r) * DM) + lane;
#pragma unroll
        for (int j = 0; j < 4; ++j) { const u32x2 w = __builtin_nontemporal_load(&xr[64 * j]); v[r][j] = (f32x4){bflo(w.x), bfhi(w.x), bflo(w.y), bfhi(w.y)};
          s[r] += (v[r][j][0] * v[r][j][0] + v[r][j][1] * v[r][j][1]) + (v[r][j][2] * v[r][j][2] + v[r][j][3] * v[r][j][3]); }
      }
#pragma unroll
      for (int r = 0; r < 2; ++r) {
        const float rstd = 1.f / sqrtf(wave_sum(s[r]) * (1.f / DM) + 1e-6f);
        f32x4* orow = (f32x4*)(P.out + (size_t)(row0 + r) * DM) + lane;
#pragma unroll
        for (int j = 0; j < 4; ++j) { const f32x4 gg = ((const f32x4*)P.in[33])[lane + 64 * j]; __builtin_nontemporal_store(v[r][j] * rstd * gg, &orow[64 * j]); }
      }
    } }
}

extern "C" void kernel_launch(void* const* d_in, const int* in_sizes, int n_in, void* d_out, int out_size,
                              void* d_ws, size_t ws_size, hipStream_t stream) {
  static int grid_blocks = 0;
  if (!grid_blocks) {
    int dev = 0, cus = 0, per_cu = 0;
    (void)hipGetDevice(&dev);
    (void)hipDeviceGetAttribute(&cus, hipDeviceAttributeMultiprocessorCount, dev);
    (void)hipFuncSetAttribute((const void*)mega, hipFuncAttributeMaxDynamicSharedMemorySize, LDS_BYTES);
    (void)hipOccupancyMaxActiveBlocksPerMultiprocessor(&per_cu, (const void*)mega, NT, LDS_BYTES);
    if (per_cu < 1) { fprintf(stderr, "kernel_launch: occupancy query says %d blocks/CU\n", per_cu); per_cu = 1; }
    grid_blocks = cus;
    if (n_in != 34 || out_size != NTOK * DM || ws_size < WS_END)
      fprintf(stderr, "kernel_launch: unexpected sizes n_in %d out %d ws %zu (need %zu)\n", n_in, out_size, ws_size, (size_t)WS_END);
  }
  (void)hipMemsetAsync((unsigned char*)d_ws + OFF_BAR, 0, XCD_BAR_WORDS * 4, stream);
  Params p{};
  for (int i = 0; i < 34; ++i) p.in[i] = (const float*)d_in[i];
  p.out = (float*)d_out; p.ws = (unsigned char*)d_ws;
  void* args[] = {&p};
  hipError_t e = hipLaunchCooperativeKernel((void*)mega, dim3(grid_blocks), dim3(NT), args, LDS_BYTES, stream);
  if (e != hipSuccess) fprintf(stderr, "cooperative launch failed: %s (grid %d)\n", hipGetErrorString(e), grid_blocks);
}
```
